# Optimizing an MI355X kernel written in HIP

```python
import math
import jax, jax.numpy as jnp
from jax import lax
import numpy as np

D_MODEL = 1024
BATCH = 2
SEQ = 8192
DEPTH = 2

N_ATT_HEADS = 4
ATT_HEAD_DIM = D_MODEL // 16
ATT_WIDTH = N_ATT_HEADS * 2 * ATT_HEAD_DIM
N_SGU_GROUPS = 4
SGU_CHUNK = 128
SGU_WIDTH = D_MODEL - ATT_WIDTH
SGU_GROUP_DIM = SGU_WIDTH // N_SGU_GROUPS
D_MIX = ATT_WIDTH + SGU_WIDTH
D_IN_PROJ = 3 * ATT_WIDTH + 2 * SGU_WIDTH
D_FF = 2816
CONV_WIDTH = 3
Q_BLOCK = 128
NORM_EPS = 1e-6
SUBLN_EPS = 1e-5
LN_EPS = 1e-5
NEG_INF = -1e30

kernel_name = 'hybrid_diffattn_sgu_convffn'


def _rmsnorm(x, g, eps=NORM_EPS):
    xf = x.astype(jnp.float32)
    y = xf * lax.rsqrt(jnp.mean(xf * xf, axis=-1, keepdims=True) + eps)
    return (y * g.astype(jnp.float32)).astype(x.dtype)


def _layernorm(x, g, b, eps=LN_EPS):
    xf = x.astype(jnp.float32)
    mu = jnp.mean(xf, axis=-1, keepdims=True)
    xc = xf - mu
    y = xc * lax.rsqrt(jnp.mean(xc * xc, axis=-1, keepdims=True) + eps)
    return (y * g.astype(jnp.float32) + b.astype(jnp.float32)).astype(x.dtype)


def _alibi_slopes(n_heads):
    return jnp.asarray([2.0 ** (-8.0 * (h + 1) / n_heads) for h in range(n_heads)], dtype=jnp.float32)


def _lambda_init(layer_idx):
    return 0.8 - 0.6 * math.exp(-0.3 * layer_idx)


def _diff_attention(q1, q2, k1, k2, v, lam):
    b, h, s, d = q1.shape
    nb = s // Q_BLOCK
    scale = d ** -0.5
    slopes = _alibi_slopes(h)
    kpos = jnp.arange(s)
    qb1 = q1.reshape(b, h, nb, Q_BLOCK, d).transpose(2, 0, 1, 3, 4)
    qb2 = q2.reshape(b, h, nb, Q_BLOCK, d).transpose(2, 0, 1, 3, 4)

    def block(args):
        qa, qb, i = args
        qpos = i * Q_BLOCK + jnp.arange(Q_BLOCK)
        dist = (qpos[:, None] - kpos[None, :]).astype(jnp.float32)
        bias = -slopes[:, None, None] * dist
        causal = dist >= 0
        s1 = jnp.einsum('bhqd,bhkd->bhqk', qa, k1).astype(jnp.float32) * scale + bias
        s2 = jnp.einsum('bhqd,bhkd->bhqk', qb, k2).astype(jnp.float32) * scale + bias
        p1 = jax.nn.softmax(jnp.where(causal, s1, NEG_INF), axis=-1)
        p2 = jax.nn.softmax(jnp.where(causal, s2, NEG_INF), axis=-1)
        p = (p1 - lam * p2).astype(v.dtype)
        return jnp.einsum('bhqk,bhkd->bhqd', p, v)

    out = lax.map(block, (qb1, qb2, jnp.arange(nb)))
    return out.transpose(1, 2, 0, 3, 4).reshape(b, h, s, 2 * d)


def _spatial_gating(u, vg, ln_g, ln_b, w_s, b_s):
    b, s, _ = u.shape
    nc = s // SGU_CHUNK
    u = jax.nn.gelu(u)
    vg = jax.nn.gelu(vg).reshape(b, s, N_SGU_GROUPS, SGU_GROUP_DIM)
    vg = _layernorm(vg, ln_g.reshape(N_SGU_GROUPS, SGU_GROUP_DIM), ln_b.reshape(N_SGU_GROUPS, SGU_GROUP_DIM))
    vg = vg.reshape(b, nc, SGU_CHUNK, N_SGU_GROUPS, SGU_GROUP_DIM)
    tril = jnp.tril(jnp.ones((SGU_CHUNK, SGU_CHUNK), dtype=bool))
    w_m = jnp.where(tril[None], w_s, jnp.zeros_like(w_s))
    vmix = jnp.einsum('gts,bnsgc->bntgc', w_m, vg) + b_s.T[None, None, :, :, None]
    return u * vmix.reshape(b, s, SGU_WIDTH)


def _causal_dwconv(x, w, bias):
    s = x.shape[1]
    xp = jnp.pad(x, ((0, 0), (CONV_WIDTH - 1, 0), (0, 0)))
    out = bias
    for j in range(CONV_WIDTH):
        out = out + w[j] * xp[:, j:j + s]
    return out


def setup_inputs(seed: int = 0) -> dict:
    key = jax.random.key(seed)
    ks = jax.random.split(key, 20)
    f32 = jnp.float32
    nrm = lambda k, shp, sc: jax.random.normal(k, shp, f32) * sc
    d = ATT_HEAD_DIM
    return {
        'x': nrm(ks[0], (BATCH, SEQ, D_MODEL), 1.0),
        'norm1_g': 1.0 + nrm(ks[1], (DEPTH, D_MODEL), 0.02),
        'w_in': nrm(ks[2], (DEPTH, D_MODEL, D_IN_PROJ), D_MODEL ** -0.5),
        'lam_q1': nrm(ks[3], (DEPTH, d), 0.1),
        'lam_k1': nrm(ks[4], (DEPTH, d), 0.1),
        'lam_q2': nrm(ks[5], (DEPTH, d), 0.1),
        'lam_k2': nrm(ks[6], (DEPTH, d), 0.1),
        'subln_g': 1.0 + nrm(ks[7], (DEPTH, 2 * d), 0.02),
        'sgu_ln_g': 1.0 + nrm(ks[8], (DEPTH, SGU_WIDTH), 0.02),
        'sgu_ln_b': nrm(ks[9], (DEPTH, SGU_WIDTH), 0.02),
        'sgu_w': nrm(ks[10], (DEPTH, N_SGU_GROUPS, SGU_CHUNK, SGU_CHUNK), SGU_CHUNK ** -0.5),
        'sgu_b': 1.0 + nrm(ks[11], (DEPTH, N_SGU_GROUPS, SGU_CHUNK), 0.02),
        'w_out': nrm(ks[12], (DEPTH, D_MIX, D_MODEL), D_MIX ** -0.5),
        'norm2_g': 1.0 + nrm(ks[13], (DEPTH, D_MODEL), 0.02),
        'ffn_w_up': nrm(ks[14], (DEPTH, D_MODEL, 2 * D_FF), D_MODEL ** -0.5),
        'ffn_conv_w': nrm(ks[15], (DEPTH, CONV_WIDTH, 2 * D_FF), CONV_WIDTH ** -0.5),
        'ffn_conv_b': nrm(ks[16], (DEPTH, 2 * D_FF), 0.02),
        'ffn_w_down': nrm(ks[17], (DEPTH, D_FF, D_MODEL), D_FF ** -0.5),
        'final_g': 1.0 + nrm(ks[18], (D_MODEL,), 0.02),
    }


def reference(x, norm1_g, w_in, lam_q1, lam_k1, lam_q2, lam_k2, subln_g, sgu_ln_g, sgu_ln_b,
              sgu_w, sgu_b, w_out, norm2_g, ffn_w_up, ffn_conv_w, ffn_conv_b, ffn_w_down, final_g):
    b, s, _ = x.shape
    h_, d = N_ATT_HEADS, ATT_HEAD_DIM
    for l in range(DEPTH):
        lam_init = _lambda_init(l)
        h = _rmsnorm(x, norm1_g[l])
        z = h @ w_in[l]
        q, k, v, u, vg = jnp.split(z, [ATT_WIDTH, 2 * ATT_WIDTH, 3 * ATT_WIDTH, 3 * ATT_WIDTH + SGU_WIDTH], axis=-1)
        q = q.reshape(b, s, h_, 2, d).transpose(3, 0, 2, 1, 4)
        k = k.reshape(b, s, h_, 2, d).transpose(3, 0, 2, 1, 4)
        v = v.reshape(b, s, h_, 2 * d).transpose(0, 2, 1, 3)
        lam = (jnp.exp(jnp.sum(lam_q1[l].astype(jnp.float32) * lam_k1[l].astype(jnp.float32)))
               - jnp.exp(jnp.sum(lam_q2[l].astype(jnp.float32) * lam_k2[l].astype(jnp.float32)))
               + lam_init)
        att = _diff_attention(q[0], q[1], k[0], k[1], v, lam)
        att = _rmsnorm(att, subln_g[l], SUBLN_EPS) * (1.0 - lam_init)
        att = att.transpose(0, 2, 1, 3).reshape(b, s, ATT_WIDTH)
        sgu = _spatial_gating(u, vg, sgu_ln_g[l], sgu_ln_b[l], sgu_w[l], sgu_b[l])
        x = x + jnp.concatenate([att, sgu], axis=-1) @ w_out[l]
        h2 = _rmsnorm(x, norm2_g[l])
        up = _causal_dwconv(h2 @ ffn_w_up[l], ffn_conv_w[l], ffn_conv_b[l])
        gate, val = jnp.split(up, 2, axis=-1)
        x = x + (jax.nn.gelu(gate) * val) @ ffn_w_down[l]
    return _rmsnorm(x, final_g)
```

```cpp
#include <hip/hip_runtime.h>
#include <hip/hip_cooperative_groups.h>
#include <cstdio>
#include <cstdint>
#include <cmath>
#include <hip/hip_bf16.h>
namespace cg = cooperative_groups;
#ifndef REP_ATT
#define REP_ATT 1
#endif
#ifndef REP_P4
#define REP_P4 1
#endif
#ifndef REP_P1
#define REP_P1 1
#endif
#ifndef REP_P2B
#define REP_P2B 1
#endif
#ifndef REP_P0
#define REP_P0 1
#endif
#ifndef REP_SYNC
#define REP_SYNC 0
#endif
#ifndef REP_SGU
#define REP_SGU 1
#endif
#ifndef FUSE_SGU
#define FUSE_SGU 1
#endif
#ifndef PH
#define PH 63
#endif
namespace pg8 {
#define PG8_LAS __attribute__((address_space(3)))
typedef unsigned short bf16_t;
typedef short bf16x8 __attribute__((ext_vector_type(8)));
typedef float f32x4 __attribute__((ext_vector_type(4)));
typedef unsigned u32x4 __attribute__((ext_vector_type(4)));
constexpr int BM = 256, BK = 64, HALF = 128, HTB = HALF * BK * 2  , STAGE_BYTES = 8 * HTB, NXCD = 8, WGM = 8;

__host__ __device__ __forceinline__ int lds_byte(int r, int c) { const int st = (r >> 4) * 2 + (c >> 5), rr = r & 15, cc = c & 31, ob = rr * 64 + cc * 2; return st * 1024 + (ob ^ (((ob >> 9) & 1) << 5)); }
__host__ __device__ __forceinline__ void stage_rc(int b, int& R, int& C) { const int st = b / 1024, sb = b % 1024, swz = sb ^ (((sb >> 9) & 1) << 5); R = (st >> 1) * 16 + swz / 64; C = (st & 1) * 32 + (swz % 64) / 2; }
__host__ __device__ __forceinline__ int perm32(int rho) { const int n = rho >> 4, i = rho & 15; return 8 * (i >> 2) + 4 * n + (i & 3); }

struct Unit { int pm, pn, ui; };
struct Gemm { const bf16_t* A; const bf16_t* Bt; int M, N, K; int a_tile_rows, a_half_rows, a_skip; };

struct StaticOrder {
    int nM, nN, nwg, G, c;
    __host__ __device__ void init(int M, int N, int G_, int c_) { nM = M / BM; nN = N / BM; nwg = nM * nN; G = G_; c = c_; }
    __host__ __device__ bool next(int i, Unit& u) const {
        const long L = (long)i * G + c; if (L >= nwg) return false;
        int wgid = (int)L; { const int q = nwg / NXCD, r = nwg % NXCD, xcd = wgid % NXCD, off = wgid / NXCD; wgid = (xcd < r ? xcd * (q + 1) : r * (q + 1) + (xcd - r) * q) + off; }
        const int nig = WGM * nN, gid = wgid / nig, fm = gid * WGM, gsz = (nM - fm) < WGM ? (nM - fm) : WGM;
        u.pm = fm + ((wgid % nig) % gsz); u.pn = (wgid % nig) / gsz; u.ui = i; return true;
    }
    __device__ __forceinline__ void a_ready(const Unit&) const {}
    __device__ __forceinline__ void done(const Unit&) const {}
};

__device__ __forceinline__ unsigned cvt_pk_bf16(float lo, float hi) { unsigned r; asm volatile("v_cvt_pk_bf16_f32 %0, %1, %2" : "=v"(r) : "v"(lo), "v"(hi)); return r; }
template <class Epi, class Sched, bool ALIGN_EPI = false, bool SP2 = false>
__device__ __forceinline__ void gemm_phase(PG8_LAS unsigned char* lds, const Gemm g, const Sched& S, const Epi& E) {
    int tid_ = threadIdx.x; asm volatile("" : "+v"(tid_));
    const int tid = tid_, wid = __builtin_amdgcn_readfirstlane(tid >> 6), lane = tid & 63, wr = wid >> 2, wc = wid & 3, fr = lane & 15, fq = lane >> 4;
    const int K = g.K, nt = K / BK;
    unsigned voffA[2], voffB[2];
#pragma unroll
    for (int i = 0; i < 2; ++i) { int R, C; stage_rc(tid * 16 + i * 8192, R, C); const int Rb = Epi::PERM ? ((R & ~31) + perm32(R & 31)) : R;
        voffA[i] = (unsigned)((R - g.a_skip * (R >> 6)) * K + C) * 2u; voffB[i] = (unsigned)(Rb * K + C) * 2u; }
    const size_t kstep = (size_t)(BK * 2);
    const size_t hstepB = (size_t)HALF * K * 2, hstepA = (size_t)g.a_half_rows * K * 2;
    const size_t tstepB = 2 * hstepB, tstepA = (size_t)g.a_tile_rows * K * 2;
    const unsigned ldsw = (unsigned)wid * 1024u;
    const int aoff = lds_byte(wr * 64 + fr, fq * 8), boff = lds_byte(wc * 32 + fr, fq * 8);
#define PG8_SA(b, h) (((b) * 2 + (h)) * HTB)
#define PG8_SB(b, h) ((4 + (b) * 2 + (h)) * HTB)
#define PG8_STAGE(bufoff, gbase, voff) do { _Pragma("unroll") for (int _i = 0; _i < 2; ++_i) \
        __builtin_amdgcn_global_load_lds((const unsigned*)((const char*)(gbase) + (voff)[_i]), (PG8_LAS unsigned*)(lds + (bufoff) + ldsw + _i * 8192), 16, 0, 0); } while (0)
#define PG8_LDA(dst, b, h) do { _Pragma("unroll") for (int m = 0; m < 4; ++m) _Pragma("unroll") for (int k = 0; k < 2; ++k) dst[m][k] = *(const PG8_LAS bf16x8*)(lds + PG8_SA(b, h) + aoff + m * 2048 + k * 1024); } while (0)
#define PG8_LDB(dst, b, h) do { _Pragma("unroll") for (int n = 0; n < 2; ++n) _Pragma("unroll") for (int k = 0; k < 2; ++k) dst[n][k] = *(const PG8_LAS bf16x8*)(lds + PG8_SB(b, h) + boff + n * 2048 + k * 1024); } while (0)
#define PG8_MMA(ai, bj, At, Bt) do { __builtin_amdgcn_s_setprio(1); _Pragma("unroll") for (int m = 0; m < 4; ++m) _Pragma("unroll") for (int n = 0; n < 2; ++n) _Pragma("unroll") for (int k = 0; k < 2; ++k) \
        acc[ai][bj][m][n] = __builtin_amdgcn_mfma_f32_16x16x32_bf16(Bt[n][k], At[m][k], acc[ai][bj][m][n], 0, 0, 0); __builtin_amdgcn_s_setprio(0); } while (0)
#define PG8_WAIT_V(n) asm volatile("s_waitcnt vmcnt(" #n ")" ::: "memory")
#define PG8_WAIT_L(n) asm volatile("s_waitcnt lgkmcnt(" #n ")" ::: "memory")
#define PG8_BAR __builtin_amdgcn_s_barrier()
#define PG8_SCHED __builtin_amdgcn_sched_barrier(0)
    Unit cur, nxt; int ui = 0;
    if (!S.next(0, cur)) return;
    f32x4 acc[2][2][4][2];
#pragma unroll
    for (int a = 0; a < 2; ++a)
#pragma unroll
        for (int b = 0; b < 2; ++b)
#pragma unroll
            for (int m = 0; m < 4; ++m)
#pragma unroll
                for (int n = 0; n < 2; ++n) acc[a][b][m][n] = (f32x4){0.f, 0.f, 0.f, 0.f};
    bf16x8 At[4][2], B0[2][2], B1[2][2];
    const char* cA = (const char*)g.A + (size_t)cur.pm * tstepA; const char* cB = (const char*)g.Bt + (size_t)cur.pn * tstepB;
    S.a_ready(cur);
    if constexpr (SP2) {
        PG8_STAGE(PG8_SB(0, 0), cB, voffB); PG8_STAGE(PG8_SB(0, 1), cB + hstepB, voffB); PG8_STAGE(PG8_SA(0, 0), cA, voffA); PG8_STAGE(PG8_SA(0, 1), cA + hstepA, voffA);
        if (wr == 1) PG8_BAR;
        PG8_WAIT_V(2); PG8_BAR;
        PG8_STAGE(PG8_SB(1, 0), cB + kstep, voffB); PG8_STAGE(PG8_SA(1, 0), cA + kstep, voffA); PG8_STAGE(PG8_SB(1, 1), cB + hstepB + kstep, voffB);
        PG8_WAIT_V(6); PG8_BAR;
    } else {
        PG8_STAGE(PG8_SB(0, 0), cB, voffB); PG8_STAGE(PG8_SA(0, 0), cA, voffA); PG8_STAGE(PG8_SB(0, 1), cB + hstepB, voffB); PG8_STAGE(PG8_SA(0, 1), cA + hstepA, voffA);
        if (wr == 1) PG8_BAR;
        PG8_WAIT_V(4); PG8_BAR;
        PG8_STAGE(PG8_SB(1, 0), cB + kstep, voffB); PG8_STAGE(PG8_SA(1, 0), cA + kstep, voffA); PG8_STAGE(PG8_SB(1, 1), cB + hstepB + kstep, voffB);
        PG8_WAIT_V(6); PG8_BAR;
    }
    for (;;) {
        const bool has_next = S.next(ui + 1, nxt);
        const char* nA = has_next ? (const char*)g.A + (size_t)nxt.pm * tstepA : cA; const char* nB = has_next ? (const char*)g.Bt + (size_t)nxt.pn * tstepB : cB;
        for (int t = 0; t < nt; t += 2) {
            const bool last = (t == nt - 2);
            const char* a1 = cA + (size_t)(t + 1) * kstep;
            const char* a2 = last ? nA : cA + (size_t)(t + 2) * kstep; const char* b2 = last ? nB : cB + (size_t)(t + 2) * kstep;
            const char* a3 = a2 + kstep; const char* b3 = b2 + kstep;
            if (last && has_next) S.a_ready(nxt);
            if constexpr (SP2) {
            PG8_LDB(B0, 0, 0); PG8_LDB(B1, 0, 1); PG8_SCHED; PG8_LDA(At, 0, 0); PG8_STAGE(PG8_SA(1, 1), a1 + hstepA, voffA);
            PG8_WAIT_V(8); PG8_WAIT_L(0); PG8_BAR; PG8_MMA(0, 0, At, B0); PG8_MMA(0, 1, At, B1); PG8_BAR; PG8_SCHED;
            PG8_LDA(At, 0, 1); PG8_STAGE(PG8_SB(0, 0), b2, voffB); PG8_STAGE(PG8_SB(0, 1), b2 + hstepB, voffB); PG8_STAGE(PG8_SA(0, 0), a2, voffA);
            PG8_WAIT_V(8); PG8_WAIT_L(0); PG8_BAR; PG8_MMA(1, 0, At, B0); PG8_MMA(1, 1, At, B1); PG8_BAR; PG8_SCHED;
            PG8_LDB(B0, 1, 0); PG8_LDB(B1, 1, 1); PG8_SCHED; PG8_LDA(At, 1, 0); PG8_STAGE(PG8_SA(0, 1), a2 + hstepA, voffA);
            PG8_WAIT_V(8); PG8_WAIT_L(0); PG8_BAR; PG8_MMA(0, 0, At, B0); PG8_MMA(0, 1, At, B1); PG8_BAR; PG8_SCHED;
            PG8_LDA(At, 1, 1); PG8_STAGE(PG8_SB(1, 0), b3, voffB); PG8_STAGE(PG8_SB(1, 1), b3 + hstepB, voffB); PG8_STAGE(PG8_SA(1, 0), a3, voffA);
            PG8_WAIT_V(8); PG8_WAIT_L(0); PG8_BAR; PG8_MMA(1, 0, At, B0); PG8_MMA(1, 1, At, B1); PG8_BAR; PG8_SCHED;
            } else {
            PG8_LDB(B0, 0, 0); PG8_SCHED; PG8_LDA(At, 0, 0); PG8_STAGE(PG8_SA(1, 1), a1 + hstepA, voffA);
            PG8_WAIT_L(8); PG8_BAR; PG8_WAIT_L(0); PG8_MMA(0, 0, At, B0); PG8_BAR; PG8_SCHED;
            PG8_LDB(B1, 0, 1); PG8_STAGE(PG8_SB(0, 0), b2, voffB);
            PG8_BAR; PG8_WAIT_L(0); PG8_MMA(0, 1, At, B1); PG8_BAR;
            PG8_LDA(At, 0, 1); PG8_STAGE(PG8_SA(0, 0), a2, voffA);
            PG8_BAR; PG8_WAIT_L(0); PG8_MMA(1, 0, At, B0); PG8_BAR; PG8_SCHED;
            PG8_STAGE(PG8_SB(0, 1), b2 + hstepB, voffB);
            PG8_WAIT_V(6); PG8_BAR; PG8_MMA(1, 1, At, B1); PG8_BAR;
            PG8_LDB(B0, 1, 0); PG8_SCHED; PG8_LDA(At, 1, 0); PG8_STAGE(PG8_SA(0, 1), a2 + hstepA, voffA);
            PG8_WAIT_L(8); PG8_BAR; PG8_WAIT_L(0); PG8_MMA(0, 0, At, B0); PG8_BAR; PG8_SCHED;
            PG8_LDB(B1, 1, 1); PG8_STAGE(PG8_SB(1, 0), b3, voffB);
            PG8_BAR; PG8_WAIT_L(0); PG8_MMA(0, 1, At, B1); PG8_BAR;
            PG8_LDA(At, 1, 1); PG8_STAGE(PG8_SA(1, 0), a3, voffA);
            PG8_BAR; PG8_WAIT_L(0); PG8_MMA(1, 0, At, B0); PG8_BAR; PG8_SCHED;
            PG8_STAGE(PG8_SB(1, 1), b3 + hstepB, voffB);
            PG8_WAIT_V(6); PG8_BAR; PG8_MMA(1, 1, At, B1); PG8_BAR;
            }
        }
        if constexpr (ALIGN_EPI) { if (wr == 0) PG8_BAR; }
        if constexpr (!Epi::AFTER_DRAIN) { E(acc, cur, wr, wc, fr, fq); S.done(cur); }
        if (!has_next) break;
#pragma unroll
        for (int a = 0; a < 2; ++a)
#pragma unroll
            for (int b = 0; b < 2; ++b)
#pragma unroll
                for (int m = 0; m < 4; ++m)
#pragma unroll
                    for (int n = 0; n < 2; ++n) acc[a][b][m][n] = (f32x4){0.f, 0.f, 0.f, 0.f};
        cur = nxt; cA = nA; cB = nB; ++ui;
        if constexpr (ALIGN_EPI) { if (wr == 1) PG8_BAR; }
    }
    PG8_WAIT_V(0);
    if constexpr (!ALIGN_EPI) { if (wr == 0) PG8_BAR; }
    PG8_BAR;
    if constexpr (Epi::AFTER_DRAIN) { E.fused(acc, cur, wr, wc, fr, fq, lds, wid, lane); S.done(cur); }
#undef PG8_SA
#undef PG8_SB
#undef PG8_STAGE
#undef PG8_LDA
#undef PG8_LDB
#undef PG8_MMA
#undef PG8_WAIT_V
#undef PG8_WAIT_L
#undef PG8_BAR
#undef PG8_SCHED
}
}
using pg8::bf16_t; using pg8::bf16x8; using pg8::f32x4; using pg8::u32x4;
#define LAS __attribute__((address_space(3)))
typedef float f32x16 __attribute__((ext_vector_type(16)));
typedef float f32x2 __attribute__((ext_vector_type(2)));
typedef unsigned u32x2 __attribute__((ext_vector_type(2)));
typedef short s16x4 __attribute__((ext_vector_type(4)));

constexpr int SEQ = 8192, NB = 2, M = NB * SEQ, D = 1024, DIN = 2560, DFF = 2816, NUP = 2 * DFF, DEPTH = 2;
constexpr int NH = 4, HD = 64, VD = 128;
constexpr float NORM_EPS = 1e-6f, SUBLN_EPS = 1e-5f, LN_EPS = 1e-5f;
constexpr float LOG2E = 1.4426950408889634f;
constexpr float QSCALE = 0.125f * LOG2E;
constexpr int P4_ROWS = 248, P4_TILES = (M + P4_ROWS - 1) / P4_ROWS;

constexpr size_t MiB = 1u << 20;
constexpr size_t WS_SS = 0;
constexpr size_t WS_W = 1 * MiB;
constexpr size_t W_IN = 0, W_OUT = 5 * MiB, W_UP = 7 * MiB, W_DOWN = 18 * MiB, W_LAYER = 47 * MiB / 2;
constexpr size_t WS_XB = 48 * MiB;
constexpr size_t WS_Z = 80 * MiB;
constexpr size_t WS_MIX = 160 * MiB;
constexpr size_t WS_Y = 80 * MiB;
constexpr size_t WS_OP1 = 192 * MiB;
constexpr size_t WS_CTL = 224 * MiB, CTL_BYTES = 131072;
constexpr size_t WS_END = 225 * MiB;
static_assert(WS_W + 2 * W_LAYER <= WS_XB && WS_Y + (size_t)M * DFF * 2 <= WS_OP1 && WS_MIX + (size_t)M * D * 2 <= WS_OP1, "ws map");

constexpr int RING_BYTES = 131072, LDS_BYTES = 147456;

__device__ __forceinline__ unsigned f2bf(float f) { unsigned u = __builtin_bit_cast(unsigned, f); return (u + 0x7fffu + ((u >> 16) & 1u)) >> 16; }
__device__ __forceinline__ unsigned pk2(float lo, float hi) { return f2bf(lo) | (f2bf(hi) << 16); }
__device__ __forceinline__ unsigned cvtpk(float lo, float hi) { return pg8::cvt_pk_bf16(lo, hi); }
__device__ __forceinline__ float bf2f(unsigned short b) { return __builtin_bit_cast(float, (unsigned)b << 16); }
__device__ __forceinline__ float bflo(unsigned w) { return __builtin_bit_cast(float, w << 16); }
__device__ __forceinline__ float bfhi(unsigned w) { return __builtin_bit_cast(float, w & 0xffff0000u); }
__device__ __forceinline__ float shx(float v, int mask, int lane) { return __builtin_bit_cast(float, __builtin_amdgcn_ds_bpermute((lane ^ mask) << 2, __builtin_bit_cast(int, v))); }
__device__ __forceinline__ float wave_sum(float v, int lane) {
#pragma unroll
    for (int o = 1; o < 64; o <<= 1) v += shx(v, o, lane);
    return v;
}
__device__ __forceinline__ float gelu_t(float x) {
    const float u = x * (1.0f + 0.044715f * x * x);
    const float e = __builtin_amdgcn_exp2f(-2.302208198f * u);
    return x * __builtin_amdgcn_rcpf(1.0f + e);
}
__device__ __forceinline__ f32x2 gelu_t2(f32x2 x) {
    f32x2 t = x * x; t = t * 0.044715f + 1.0f; const f32x2 u = (x * t) * (-2.302208198f);
    f32x2 e; e.x = __builtin_amdgcn_exp2f(u.x); e.y = __builtin_amdgcn_exp2f(u.y); e = e + 1.0f;
    f32x2 r; r.x = __builtin_amdgcn_rcpf(e.x); r.y = __builtin_amdgcn_rcpf(e.y);
    return x * r;
}
__device__ __forceinline__ float row_rstd(const float* ss, int row, float eps) {
    const f32x4* p = (const f32x4*)(ss + (size_t)row * 16);
    const f32x4 a = p[0], b = p[1], c = p[2], d = p[3];
    const float s = (((a[0] + a[1]) + (a[2] + a[3])) + ((b[0] + b[1]) + (b[2] + b[3]))) + (((c[0] + c[1]) + (c[2] + c[3])) + ((d[0] + d[1]) + (d[2] + d[3])));
    return __builtin_amdgcn_rsqf(s * (1.0f / D) + eps);
}
constexpr int RSTAB_OFF = RING_BYTES;
template <bool P4MAP, class Sched> __device__ __forceinline__ void fill_rstd(LAS unsigned char* lds, const Sched& S, const float* ss) {
    int t = threadIdx.x; asm volatile("" : "+v"(t));
    LAS float* tab = (LAS float*)(lds + RSTAB_OFF); pg8::Unit u;
    const int r = t & 255, h = t >> 8;
#pragma unroll
    for (int k = 0; k < 4; ++k) { const int i = 2 * k + h;
        if (S.next(i, u)) {
            int tok = P4MAP ? u.pm * P4_ROWS + 62 * (r >> 6) + (r & 63) - 2 : u.pm * 256 + r; tok = tok < 0 ? 0 : (tok > M - 1 ? M - 1 : tok);
            tab[i * 256 + r] = row_rstd(ss, tok, NORM_EPS); } }
    __syncthreads();
}

struct EpiInProj {
    static constexpr bool PERM = true, AFTER_DRAIN = false;
    bf16_t* Z; LAS const float* tab; bool wt;
    __device__ __forceinline__ void operator()(f32x4 (&acc)[2][2][4][2], const pg8::Unit& u, int wr, int wc, int fr, int fq) const {
        asm volatile("" : "+v"(fr), "+v"(fq));
        const __amdgpu_buffer_rsrc_t zr = __builtin_amdgcn_make_buffer_rsrc((void*)Z, 0, M * DIN * 2, 0x00020000);
        const int row0 = u.pm * 256 + wr * 64 + fr, col0 = u.pn * 256 + wc * 32 + 8 * fq;
#pragma unroll
        for (int ai = 0; ai < 2; ++ai)
#pragma unroll
            for (int m = 0; m < 4; ++m) {
                const int row = row0 + ai * 128 + m * 16; const float rs = tab[u.ui * 256 + ai * 128 + wr * 64 + m * 16 + fr];
                bf16_t* rowp = Z + (size_t)row * DIN + col0;
#pragma unroll
                for (int bj = 0; bj < 2; ++bj) { const f32x4 v0 = acc[ai][bj][m][0] * rs, v1 = acc[ai][bj][m][1] * rs;
                    u32x4 w; w.x = cvtpk(v0[0], v0[1]); w.y = cvtpk(v0[2], v0[3]); w.z = cvtpk(v1[0], v1[1]); w.w = cvtpk(v1[2], v1[3]);
                    if (wt && u.ui == 0) __builtin_amdgcn_raw_buffer_store_b128(w, zr, (unsigned)(((size_t)row * DIN + col0 + bj * 128) * 2), 0,   16);
                    else *(u32x4*)(rowp + bj * 128) = w; }
            }
    }
};
struct InProjOrder {
    pg8::StaticOrder A, B; unsigned* cnt; bool pub;
    __device__ void init(int G_, int c_, unsigned* cnt_, bool pub_) { A.init(M, 1024, G_, c_); B.init(M, 1536, G_, c_); cnt = cnt_; pub = pub_; }
    __device__ bool next(int i, pg8::Unit& u) const { if (i == 0) { const bool ok = A.next(0, u); u.pn += 6; u.ui = 0; return ok; } const bool ok = B.next(i - 1, u); u.ui = i; return ok; }
    __device__ __forceinline__ void a_ready(const pg8::Unit&) const {}
    __device__ __forceinline__ void done(const pg8::Unit& u) const {
        if (pub && u.ui == 0) { asm volatile("s_waitcnt vmcnt(0)" ::: "memory"); __builtin_amdgcn_s_barrier(); asm volatile("" ::: "memory");
            if (threadIdx.x == 0) __hip_atomic_fetch_add(cnt, 1u, __ATOMIC_RELAXED, __HIP_MEMORY_SCOPE_AGENT); }
    }
};
struct EpiRes {
    static constexpr bool PERM = true, AFTER_DRAIN = false;
    const float* resf; bf16_t* xb; float* ss;
    __device__ __forceinline__ void operator()(f32x4 (&acc)[2][2][4][2], const pg8::Unit& u, int wr, int wc, int fr, int fq) const {
        asm volatile("" : "+v"(fr), "+v"(fq));
        const int col0 = u.pn * 256 + wc * 32 + 8 * fq;
#pragma unroll
        for (int ai = 0; ai < 2; ++ai)
#pragma unroll
            for (int m = 0; m < 4; ++m) {
                const int row = u.pm * 256 + ai * 128 + wr * 64 + m * 16 + fr; float sq = 0.f;
#pragma unroll
                for (int bj = 0; bj < 2; ++bj) { const size_t off = (size_t)row * D + col0 + bj * 128;
                    f32x4 r0, r1;
                    if (resf) { r0 = *(const f32x4*)(resf + off); r1 = *(const f32x4*)(resf + off + 4); }
                    else { const u32x4 w = *(const u32x4*)(xb + off); r0 = (f32x4){bflo(w.x), bfhi(w.x), bflo(w.y), bfhi(w.y)}; r1 = (f32x4){bflo(w.z), bfhi(w.z), bflo(w.w), bfhi(w.w)}; }
                    const f32x4 o0 = r0 + acc[ai][bj][m][0], o1 = r1 + acc[ai][bj][m][1];
                    sq += ((o0[0] * o0[0] + o0[1] * o0[1]) + (o0[2] * o0[2] + o0[3] * o0[3])) + ((o1[0] * o1[0] + o1[1] * o1[1]) + (o1[2] * o1[2] + o1[3] * o1[3]));
                    u32x4 w; w.x = cvtpk(o0[0], o0[1]); w.y = cvtpk(o0[2], o0[3]); w.z = cvtpk(o1[0], o1[1]); w.w = cvtpk(o1[2], o1[3]);
                    *(u32x4*)(xb + off) = w; }
                { const int ln_ = fq * 16 + fr; sq += shx(sq, 16, ln_); sq += shx(sq, 32, ln_); }
                if (fq == 0) ss[(size_t)row * 16 + u.pn * 4 + wc] = sq;
            }
    }
};
struct EpiResFinal {
    static constexpr bool PERM = true, AFTER_DRAIN = false;
    const bf16_t* xb; float* ss; float* out; const float* fg; unsigned* cnt; LAS float* tab;
    __device__ __forceinline__ void operator()(f32x4 (&acc)[2][2][4][2], const pg8::Unit& u, int wr, int wc, int fr, int fq) const {
        asm volatile("" : "+v"(fr), "+v"(fq));
        const int col0 = u.pn * 256 + wc * 32 + 8 * fq;
#pragma unroll
        for (int ai = 0; ai < 2; ++ai)
#pragma unroll
            for (int m = 0; m < 4; ++m) {
                const int row = u.pm * 256 + ai * 128 + wr * 64 + m * 16 + fr; float sq = 0.f;
#pragma unroll
                for (int bj = 0; bj < 2; ++bj) { const size_t off = (size_t)row * D + col0 + bj * 128;
                    const u32x4 w = *(const u32x4*)(xb + off);
                    const f32x4 o0 = (f32x4){bflo(w.x), bfhi(w.x), bflo(w.y), bfhi(w.y)} + acc[ai][bj][m][0], o1 = (f32x4){bflo(w.z), bfhi(w.z), bflo(w.w), bfhi(w.w)} + acc[ai][bj][m][1];
                    sq += ((o0[0] * o0[0] + o0[1] * o0[1]) + (o0[2] * o0[2] + o0[3] * o0[3])) + ((o1[0] * o1[0] + o1[1] * o1[1]) + (o1[2] * o1[2] + o1[3] * o1[3]));
                    acc[ai][bj][m][0] = o0; acc[ai][bj][m][1] = o1; }
                { const int ln_ = fq * 16 + fr; sq += shx(sq, 16, ln_); sq += shx(sq, 32, ln_); }
                if (fq == 0) __hip_atomic_store(ss + (size_t)row * 16 + u.pn * 4 + wc, sq, __ATOMIC_RELAXED, __HIP_MEMORY_SCOPE_AGENT);
            }
        asm volatile("s_waitcnt vmcnt(0)" ::: "memory"); __builtin_amdgcn_s_barrier(); asm volatile("" ::: "memory");
        int t = threadIdx.x; asm volatile("" : "+v"(t));
        if (t == 0) { unsigned* c = cnt + 64 * u.pm; __hip_atomic_fetch_add(c, 1u, __ATOMIC_RELAXED, __HIP_MEMORY_SCOPE_AGENT);
            unsigned sp = 0; while (__hip_atomic_load(c, __ATOMIC_RELAXED, __HIP_MEMORY_SCOPE_AGENT) < 4u) { __builtin_amdgcn_s_sleep(1); if (++sp > (1u << 22)) break; }
            __builtin_amdgcn_fence(__ATOMIC_ACQUIRE, "agent"); asm volatile("s_waitcnt vmcnt(0)" ::: "memory"); }
        __builtin_amdgcn_s_barrier(); asm volatile("" ::: "memory");
        if (t < 256) tab[t] = row_rstd(ss, u.pm * 256 + t, NORM_EPS);
        asm volatile("s_waitcnt lgkmcnt(0)" ::: "memory"); __builtin_amdgcn_s_barrier(); asm volatile("" ::: "memory");
        f32x4 g0[2], g1[2];
#pragma unroll
        for (int bj = 0; bj < 2; ++bj) { g0[bj] = *(const f32x4*)(fg + col0 + bj * 128); g1[bj] = *(const f32x4*)(fg + col0 + bj * 128 + 4); }
#pragma unroll
        for (int ai = 0; ai < 2; ++ai)
#pragma unroll
            for (int m = 0; m < 4; ++m) {
                const int lr = ai * 128 + wr * 64 + m * 16 + fr; const float rs = tab[lr]; float* op = out + (size_t)(u.pm * 256 + lr) * D + col0;
#pragma unroll
                for (int bj = 0; bj < 2; ++bj) { __builtin_nontemporal_store(acc[ai][bj][m][0] * rs * g0[bj], (f32x4*)(op + bj * 128)); __builtin_nontemporal_store(acc[ai][bj][m][1] * rs * g1[bj], (f32x4*)(op + bj * 128 + 4)); }
            }
    }
};
template <int CTRL> __device__ __forceinline__ float dppf(float old, float src) {
    return __builtin_bit_cast(float, __builtin_amdgcn_update_dpp(__builtin_bit_cast(int, old), __builtin_bit_cast(int, src), CTRL, 0xf, 0xf, false)); }
template <int CTRL> __device__ __forceinline__ float dppz(float src) {
    return __builtin_bit_cast(float, __builtin_amdgcn_mov_dpp(__builtin_bit_cast(int, src), CTRL, 0xf, 0xf, true)); }
struct EpiConvGate {
    static constexpr bool PERM = true, AFTER_DRAIN = false;
    bf16_t* Y; LAS const float* tab; const float* cw; const float* cb;
    template <bool MASK> __device__ __forceinline__ void run(f32x4 (&acc)[2][2][4][2], const pg8::Unit& u, int wr, int wc, int fr, int fq) const {
        const int ch0 = u.pn * 128 + wc * 32 + 8 * fq;
#pragma unroll
        for (int n = 0; n < 2; ++n) {
            asm volatile("" ::: "memory");
            const int ch = ch0 + 4 * n;
            f32x4 w0[2], w1[2], w2[2], bb[2];
#pragma unroll
            for (int bj = 0; bj < 2; ++bj) { const int col = bj * DFF + ch;
                w0[bj] = *(const f32x4*)(cw + col); w1[bj] = *(const f32x4*)(cw + NUP + col); w2[bj] = *(const f32x4*)(cw + 2 * NUP + col); bb[bj] = *(const f32x4*)(cb + col); }
#pragma unroll
            for (int ai = 0; ai < 2; ++ai)
#pragma unroll
                for (int m = 0; m < 4; ++m) {
                    const int tok = u.pm * P4_ROWS + 62 * (2 * ai + wr) + 16 * m + fr - 2; const int tpos = tok & (SEQ - 1);
                    f32x4 o[2];
#pragma unroll
                    for (int bj = 0; bj < 2; ++bj) {
                        const f32x4 cur = acc[ai][bj][m][n]; const f32x4 prv = acc[ai][bj][m > 0 ? m - 1 : 0][n];
                        f32x4 p1, p2;
#pragma unroll
                        for (int i = 0; i < 4; ++i) {
                            p1[i] = dppf<0x111>(dppz<0x10f>(prv[i]), cur[i]);
                            p2[i] = dppf<0x112>(dppz<0x10e>(prv[i]), cur[i]);
                            if (MASK) { p1[i] = tpos >= 1 ? p1[i] : 0.f; p2[i] = tpos >= 2 ? p2[i] : 0.f; }
                        }
                        o[bj] = bb[bj] + w2[bj] * cur + w1[bj] * p1 + w0[bj] * p2;
                    }
                    const f32x2 ga = gelu_t2((f32x2){o[0][0], o[0][1]}) * (f32x2){o[1][0], o[1][1]}, gb = gelu_t2((f32x2){o[0][2], o[0][3]}) * (f32x2){o[1][2], o[1][3]};
                    u32x2 w; w.x = cvtpk(ga.x, ga.y); w.y = cvtpk(gb.x, gb.y);
                    if ((m > 0 || fr >= 2) && tok < M) *(u32x2*)(Y + (size_t)tok * DFF + ch) = w;
                }
        }
    }
    __device__ __forceinline__ void operator()(f32x4 (&acc)[2][2][4][2], const pg8::Unit& u, int wr, int wc, int fr, int fq) const {
        asm volatile("" : "+v"(fr), "+v"(fq));
#pragma unroll
        for (int ai = 0; ai < 2; ++ai)
#pragma unroll
            for (int m = 0; m < 4; ++m) {
                const float rs = tab[u.ui * 256 + ai * 128 + wr * 64 + m * 16 + fr];
#pragma unroll
                for (int bj = 0; bj < 2; ++bj)
#pragma unroll
                    for (int n = 0; n < 2; ++n) acc[ai][bj][m][n] *= rs;
            }
        const int t0 = u.pm * P4_ROWS - 2;
        if (((t0 + 255) >> 13) != ((t0 - 2) >> 13)) run<true>(acc, u, wr, wc, fr, fq); else run<false>(acc, u, wr, wc, fr, fq);
    }
};
namespace attn_body {
using bf16=__hip_bfloat16;
using bf16x8=__attribute__((ext_vector_type(8)))short;
using s16x4=__attribute__((ext_vector_type(4)))short;
using f32x16=__attribute__((ext_vector_type(16)))float;
using u32x4=__attribute__((ext_vector_type(4)))unsigned;
constexpr int SEQ=8192,D=64,ZP=2560,OP=512;
constexpr int NW=8,QBLK=32,QB=QBLK*NW,KVBLK=64,NQB=SEQ/QB;
constexpr int ATTN_UNIT_ROWS=QB;
__device__ __forceinline__ int crow(int r,int hi){return (r&3)+8*(r>>2)+4*hi;}
#define SBAR() __builtin_amdgcn_sched_barrier(0)
__device__ __forceinline__ void cmask(f32x16&p0,f32x16&p1,int jb,int qrel,int hi){
  const float NEG=-INFINITY; int kb=64*jb+4*hi;
  #pragma unroll
  for(int r=0;r<16;++r){int kv=kb+(r&3)+8*(r>>2); if(kv>qrel)p0[r]=NEG; if(kv+32>qrel)p1[r]=NEG;}
}

constexpr int NSLOT=3, SLOTB=8192;
constexpr int LDS_K=0, LDS_V=NSLOT*SLOTB, LDS_WS=LDS_V+NSLOT*2*SLOTB, LDS_OST=LDS_WS+NW*64*4, LDS_BYTES=LDS_OST+NW*8192;
constexpr float C2=0.125f*1.4426950408889634f;
__device__ __forceinline__ void glds16(const void*gsrc,unsigned lds_dst){unsigned keep;
  asm volatile("s_mov_b32 %0, m0\n\ts_mov_b32 m0, %2\n\ts_nop 0\n\tglobal_load_lds_dwordx4 %1, off\n\ts_mov_b32 m0, %0":"=&s"(keep):"v"(gsrc),"s"(lds_dst):"memory");}
__device__ __forceinline__ float max3f(float a,float b,float c){float r;asm("v_max3_f32 %0, %1, %2, %3":"=v"(r):"v"(a),"v"(b),"v"(c));return r;}
__device__ __forceinline__ float max2f(float a,float b){float r;asm("v_max_f32_e32 %0, %1, %2":"=v"(r):"v"(a),"v"(b));return r;}
__device__ __forceinline__ float fadd_s(float a,float b){float r;asm("v_add_f32_e32 %0, %1, %2":"=v"(r):"v"(a),"v"(b));return r;}
__device__ __forceinline__ float fsub_s(float a,float b){float r;asm("v_sub_f32_e32 %0, %1, %2":"=v"(r):"v"(a),"v"(b));return r;}
typedef float f32x2_t __attribute__((ext_vector_type(2))); typedef float f32x4_t __attribute__((ext_vector_type(4))); typedef __bf16 bf16x2_t __attribute__((ext_vector_type(2)));
__device__ __forceinline__ unsigned cvtpk_s(float lo,float hi){f32x2_t v={lo,hi};bf16x2_t b=__builtin_convertvector(v,bf16x2_t);return __builtin_bit_cast(unsigned,b);}
__device__ __forceinline__ float bfr(float x){unsigned u=__float_as_uint(x);u=(u+0x7fffu+((u>>16)&1u))&0xffff0000u;return __uint_as_float(u);}
#define WAIT_BAR(N) asm volatile("s_waitcnt vmcnt(" #N ") lgkmcnt(0)\n\ts_barrier":::"memory")

__device__ __forceinline__ void qkt(f32x16&p0,f32x16&p1,const char*Kslot,const bf16x8*qr,const f32x16&c0,const f32x16&c1,int r32,int hi){
  const char*kb=Kslot+hi*1024+r32*16;
  #pragma unroll
  for(int d0=0;d0<4;++d0){
    const bf16x8 b0=*reinterpret_cast<const bf16x8*>(kb+d0*2048);
    const bf16x8 b1=*reinterpret_cast<const bf16x8*>(kb+d0*2048+512);
    if(d0==0){p0=__builtin_amdgcn_mfma_f32_32x32x16_bf16(b0,qr[0],c0,0,0,0);p1=__builtin_amdgcn_mfma_f32_32x32x16_bf16(b1,qr[0],c1,0,0,0);}
    else{p0=__builtin_amdgcn_mfma_f32_32x32x16_bf16(b0,qr[d0],p0,0,0,0);p1=__builtin_amdgcn_mfma_f32_32x32x16_bf16(b1,qr[d0],p1,0,0,0);}}
}
typedef __attribute__((address_space(3))) const char* lds_cptr;
typedef short v4i16_t __attribute__((ext_vector_type(4)));
__device__ __forceinline__ void kload8(bf16x8*kf,lds_cptr kp){
  kf[0]=*(const __attribute__((address_space(3))) bf16x8*)(kp);      kf[1]=*(const __attribute__((address_space(3))) bf16x8*)(kp+512);
  kf[2]=*(const __attribute__((address_space(3))) bf16x8*)(kp+2048); kf[3]=*(const __attribute__((address_space(3))) bf16x8*)(kp+2560);
  kf[4]=*(const __attribute__((address_space(3))) bf16x8*)(kp+4096); kf[5]=*(const __attribute__((address_space(3))) bf16x8*)(kp+4608);
  kf[6]=*(const __attribute__((address_space(3))) bf16x8*)(kp+6144); kf[7]=*(const __attribute__((address_space(3))) bf16x8*)(kp+6656);
}
__device__ __forceinline__ void kload2(bf16x8*kf,lds_cptr kp,int j){ kf[2*j]=*(const __attribute__((address_space(3))) bf16x8*)(kp+j*2048); kf[2*j+1]=*(const __attribute__((address_space(3))) bf16x8*)(kp+j*2048+512); }
__device__ __forceinline__ s16x4 vtr(lds_cptr p){ return __builtin_bit_cast(s16x4,__builtin_amdgcn_ds_read_tr16_b64_v4i16((__attribute__((address_space(3))) v4i16_t*)p)); }
__device__ __forceinline__ float rowmax(const f32x16&p0,const f32x16&p1){
  float a=max3f(p0[0],p0[1],p1[0]),b=max3f(p0[2],p0[3],p1[1]);a=max3f(a,p1[2],p1[3]);
  #pragma unroll
  for(int r=4;r<16;r+=4){a=max3f(a,p0[r],p0[r+1]);b=max3f(b,p0[r+2],p0[r+3]);a=max3f(a,p1[r],p1[r+1]);b=max3f(b,p1[r+2],p1[r+3]);}
  const float m=max2f(a,b);
  auto rr=__builtin_amdgcn_permlane32_swap(__float_as_uint(m),__float_as_uint(m),false,false);
  return max2f(__uint_as_float(rr[0]),__uint_as_float(rr[1]));
}
__device__ __forceinline__ void pv(f32x16*o,int vb,bf16x8 pa0,bf16x8 pa1,bf16x8 pa2,bf16x8 pa3){
  #pragma unroll
  for(int d0=0;d0<4;++d0){s16x4 lo[4],hi[4];
    #pragma unroll
    for(int ks=0;ks<4;++ks){
      asm volatile("ds_read_b64_tr_b16 %0,%1 offset:%c2":"=&v"(lo[ks]):"v"(vb),"i"(d0*4096+ks*1024):"memory");
      asm volatile("ds_read_b64_tr_b16 %0,%1 offset:%c2":"=&v"(hi[ks]):"v"(vb),"i"(d0*4096+ks*1024+512):"memory");}
    asm volatile("s_waitcnt lgkmcnt(0)":::"memory");SBAR();
    #define PK(k) (bf16x8){lo[k][0],lo[k][1],lo[k][2],lo[k][3],hi[k][0],hi[k][1],hi[k][2],hi[k][3]}
    o[d0]=__builtin_amdgcn_mfma_f32_32x32x16_bf16(pa0,PK(0),o[d0],0,0,0);
    o[d0]=__builtin_amdgcn_mfma_f32_32x32x16_bf16(pa1,PK(1),o[d0],0,0,0);
    o[d0]=__builtin_amdgcn_mfma_f32_32x32x16_bf16(pa2,PK(2),o[d0],0,0,0);
    o[d0]=__builtin_amdgcn_mfma_f32_32x32x16_bf16(pa3,PK(3),o[d0],0,0,0);
    #undef PK
  }
}

#ifndef ATTN_STORE16
#define ATTN_STORE16(p,v) (*(u32x4*)(p)=(v))
#endif
template<int THRL> __device__ __forceinline__ void attn_unit(int b,int qb,const bf16*Q,const bf16*__restrict__ K,const bf16*__restrict__ V,bf16*O,char*shm,float slope2,const int F_fmode,unsigned*F_flag,unsigned short*F_mixo,const float F_lam,const float F_gscale,const float*F_sg){
  int tid_=threadIdx.x; asm volatile("":"+v"(tid_));
  const int tid=tid_,lane=tid&63,r32=lane&31,hi=lane>>5; const int wid=__builtin_amdgcn_readfirstlane(tid>>6);
  const long rowbase=(long)b*SEQ; const int q0=qb*QB;
  const bf16*Qw=Q+(rowbase+q0+wid*QBLK)*ZP;
  const bf16*Kh=K+rowbase*ZP,*Vh=V+rowbase*ZP;
  const unsigned lds0=(unsigned)(uintptr_t)shm;
  float*wsf=(float*)(shm+LDS_WS)+wid*64;
  const bf16*ksrc=Kh+(long)lane*ZP+wid*8;
  const bf16*vsrc=Vh+(long)(16*(wid&3)+(lane>>2))*ZP+(wid>>2)*32+(lane&3)*8;
  const unsigned kdst=lds0+LDS_K+wid*1024, vdst=lds0+LDS_V+wid*1024;
  #define DMA_K(t,slot) glds16(ksrc+(long)(t)*KVBLK*ZP,(unsigned)__builtin_amdgcn_readfirstlane(kdst+(slot)))
  #define DMA_V(t,slot) do{ glds16(vsrc+(long)(t)*KVBLK*ZP,(unsigned)__builtin_amdgcn_readfirstlane(vdst+2*(slot))); glds16(vsrc+64+(long)(t)*KVBLK*ZP,(unsigned)__builtin_amdgcn_readfirstlane(vdst+8192+2*(slot))); }while(0)
  const int vb0=(int)(lds0+LDS_V)+((lane>>4)&1)*32+(lane&3)*8+(4*hi+((lane&15)>>2))*64;
  const char*Kbase=shm+LDS_K; bf16x8 kf[8];
  const lds_cptr shm3=(lds_cptr)shm; const lds_cptr kp0=shm3+LDS_K+hi*1024+r32*16; const lds_cptr vp0=shm3+LDS_V+((lane>>4)&1)*32+(lane&3)*8+(4*hi+((lane&15)>>2))*64;
  const int NT=(q0+QB)/KVBLK;
  bf16x8 qbf; unsigned locA,locB; constexpr unsigned kbA0=0u,kbB0=0u;
  { float sl_=slope2; asm volatile("":"+v"(sl_));
    const float a1=bfr(sl_), r1=sl_-a1, a2=bfr(r1), a3=bfr(r1-a2);
    const unsigned A1=__float_as_uint(a1)>>16,A2=__float_as_uint(a2)>>16,A3=__float_as_uint(a3)>>16,B1=__float_as_uint(64.f*a1)>>16,B2=__float_as_uint(64.f*a2)>>16,B3=__float_as_uint(64.f*a3)>>16;
    const u32x4 w=hi?(u32x4){0u,0u,0u,0u}:(u32x4){A1|(A2<<16),A3|(B1<<16),B2|(B3<<16),0u}; qbf=__builtin_bit_cast(bf16x8,w);
    locA=hi?0u:(__float_as_uint((float)r32)>>16); locB=hi?0u:(__float_as_uint((float)(r32+32))>>16); }
  const unsigned one2=hi?0u:0x3f803f80u;
  #define SETM() do{ const float mh_=bfr(mhat), ml_=mhat-mh_; u32x4 w_=__builtin_bit_cast(u32x4,qbf); w_.w=hi?0u:((__float_as_uint(-mh_)>>16)|(__float_as_uint(-ml_)&0xffff0000u)); qbf=__builtin_bit_cast(bf16x8,w_); }while(0)
  #define TRB(t) (hi?0u:(__float_as_uint((float)((t)-(NT-4)))>>16))
  #define KBIAS(t,W0,LOC,TB) ({ unsigned l_=(LOC); asm volatile("":"+v"(l_)); __builtin_bit_cast(bf16x8,(u32x4){l_|(l_<<16),l_|((TB)<<16),(TB)|((TB)<<16),one2}); })
  #define BIASC(t,W0,LOC,TB) __builtin_amdgcn_mfma_f32_32x32x16_bf16(KBIAS(t,W0,LOC,TB),qbf,f32x16{},0,0,0)
  DMA_K(0,0);DMA_V(0,0);DMA_K(1,SLOTB);
  bf16x8 qr[4];
  #pragma unroll
  for(int d0=0;d0<4;++d0)qr[d0]=*reinterpret_cast<const bf16x8*>(&Qw[(long)r32*ZP+d0*16+hi*8]);
  const int qrel=wid*QBLK+r32;
  float mhat=__builtin_ceilf(slope2*(float)(qrel+1))+16.f,l_reg=0.f;f32x16 o[4];o[0]=f32x16{};o[1]=f32x16{};o[2]=f32x16{};o[3]=f32x16{}; SETM();
  #define CMASK(P0,P1,t) do{int jb_=(t)-(NT-4); if(jb_>=0)cmask(P0,P1,jb_,qrel,hi);}while(0)
  bool resc=false;
  #define START(P0,P1) do{ const float rm=rowmax(P0,P1); resc=false; \
    { const float dl=__builtin_ceilf(__builtin_fmaxf(rm,0.f)); mhat=fadd_s(mhat,dl); \
      _Pragma("unroll") for(int r=0;r<16;++r){P0[r]=fsub_s(P0[r],dl);P1[r]=fsub_s(P1[r],dl);} \
      SETM(); } \
    _Pragma("unroll") for(int r=0;r<16;++r)P0[r]=__builtin_amdgcn_exp2f(P0[r]); }while(0)
  #define RESC() do{ if(resc){ asm volatile("s_waitcnt lgkmcnt(0)":::"memory"); \
      _Pragma("unroll") for(int d_=0;d_<4;++d_) _Pragma("unroll") for(int r=0;r<16;++r)o[d_][r]*=wsf[crow(r,hi)]; } }while(0)
  f32x16 pA0,pA1,pB0,pB1;
  int sl_prev=0,sl_cur=0,sl_next=SLOTB;
  #define ROT() do{sl_prev=sl_cur;sl_cur=sl_next;sl_next=(sl_next==(NSLOT-1)*SLOTB)?0:sl_next+SLOTB;}while(0)
  DMA_K(2,2*SLOTB);
  WAIT_BAR(4);
  { const unsigned tb0_=TRB(0); const f32x16 c0_=BIASC(0,kbA0,locA,tb0_), c1_=BIASC(0,kbB0,locB,tb0_); qkt(pA0,pA1,Kbase,qr,c0_,c1_,r32,hi); } asm volatile("s_nop 15\n\ts_nop 7":"+v"(pA0),"+v"(pA1));CMASK(pA0,pA1,0);
  START(pA0,pA1);
  _Pragma("unroll") for(int r=0;r<16;++r)pA1[r]=__builtin_amdgcn_exp2f(pA1[r]);
  WAIT_BAR(0);
  DMA_K(3,0);DMA_V(1,SLOTB);
  ROT();
  kload8(kf,kp0+sl_cur);
  WAIT_BAR(3);
  s16x4 vlo[8],vhi[8]; u32x4 pw0,pw1,pw2,pw3;
  #define PKW(P,B) cvtpk_s(P[B],P[B+1])
  #define PAF(k) __builtin_bit_cast(bf16x8,pw##k)
  #define VFR(i) (bf16x8){vlo[i][0],vlo[i][1],vlo[i][2],vlo[i][3],vhi[i][0],vhi[i][1],vhi[i][2],vhi[i][3]}
  #define PIN(x) asm volatile("":"+v"(x))
  #define MX3(a,b,c) __builtin_fmaxf(__builtin_fmaxf((a),(b)),(c))
  #define GAPA(MF,A0,A1,A2,A3,W0,W1,PW) do{ MF; sacc+=A0; sacc+=A1; sacc+=A2; sacc+=A3; PIN(sacc); W0; W1; PIN(PW); SBAR(); }while(0)
  #define EX(v) __builtin_amdgcn_exp2f(v)
  #define GAPB(MF,X,B) do{ MF; X[B]=EX(X[B]); X[B+1]=EX(X[B+1]); X[B+2]=EX(X[B+2]); X[B+3]=EX(X[B+3]); PIN(X); SBAR(); }while(0)
  #define VRD(s_,db_,ks_) do{ vlo[s_]=vtr(vp_+((db_)*4096+(ks_)*1024)); vhi[s_]=vtr(vp_+((db_)*4096+(ks_)*1024+512)); }while(0)
  #define GAPB2(MF,X,B) do{ MF; X[B]=EX(X[B]); X[B+1]=EX(X[B+1]); PIN(X); SBAR(); }while(0)
  #define KRD(G,j) do{ if(G){ kload2(kf,kp0+sl_next,j); SBAR(); } }while(0)
  #define STEP(C0,C1,P0,P1,t,GK,GV,GL) do{ SBAR(); \
    const lds_cptr vp_=vp0+2*sl_prev; \
    const unsigned tb_=TRB(t); \
    VRD(0,0,0); SBAR(); float sacc=(P0[0]+P0[1]); \
    GAPA(C0=__builtin_amdgcn_mfma_f32_32x32x16_bf16(kf[0],qr[0],BIASC(t,kbA0,locA,tb_),0,0,0), P0[2],P0[3],P0[4],P0[5],     pw0[0]=PKW(P0,0), pw0[1]=PKW(P0,2), pw0); \
    VRD(1,1,0); SBAR(); GAPA(C1=__builtin_amdgcn_mfma_f32_32x32x16_bf16(kf[1],qr[0],BIASC(t,kbB0,locB,tb_),0,0,0), P0[6],P0[7],P0[8],P0[9],     pw0[2]=PKW(P0,4), pw0[3]=PKW(P0,6), pw0); \
    VRD(2,2,0); SBAR(); GAPA(C0=__builtin_amdgcn_mfma_f32_32x32x16_bf16(kf[2],qr[1],C0,0,0,0),   P0[10],P0[11],P0[12],P0[13], pw1[0]=PKW(P0,8), pw1[1]=PKW(P0,10), pw1); \
    VRD(3,3,0); SBAR(); GAPA(C1=__builtin_amdgcn_mfma_f32_32x32x16_bf16(kf[3],qr[1],C1,0,0,0),   P0[14],P0[15],P1[0],P1[1],   pw1[2]=PKW(P0,12),pw1[3]=PKW(P0,14), pw1); \
    VRD(4,0,1); SBAR(); GAPA(C0=__builtin_amdgcn_mfma_f32_32x32x16_bf16(kf[4],qr[2],C0,0,0,0),   P1[2],P1[3],P1[4],P1[5],     pw2[0]=PKW(P1,0), pw2[1]=PKW(P1,2), pw2); \
    VRD(5,1,1); SBAR(); GAPA(C1=__builtin_amdgcn_mfma_f32_32x32x16_bf16(kf[5],qr[2],C1,0,0,0),   P1[6],P1[7],P1[8],P1[9],     pw2[2]=PKW(P1,4), pw2[3]=PKW(P1,6), pw2); \
    VRD(6,2,1); SBAR(); GAPA(C0=__builtin_amdgcn_mfma_f32_32x32x16_bf16(kf[6],qr[3],C0,0,0,0),   P1[10],P1[11],P1[12],P1[13], pw3[0]=PKW(P1,8), pw3[1]=PKW(P1,10), pw3); \
    VRD(7,3,1); SBAR(); GAPA(C1=__builtin_amdgcn_mfma_f32_32x32x16_bf16(kf[7],qr[3],C1,0,0,0),   P1[14],P1[15],0.f,0.f,       pw3[2]=PKW(P1,12),pw3[3]=PKW(P1,14), pw3); \
    l_reg+=sacc; \
    if(GK){DMA_K((t)+3,sl_cur);} if(GV){DMA_V((t)+1,sl_next);} \
    CMASK(C0,C1,t); \
    { float a=MX3(C0[0],C0[1],C1[0]),b=MX3(C0[2],C0[3],C1[1]); a=MX3(a,C1[2],C1[3]); \
      _Pragma("unroll") for(int r=4;r<16;r+=4){a=MX3(a,C0[r],C0[r+1]);b=MX3(b,C0[r+2],C0[r+3]);a=MX3(a,C1[r],C1[r+1]);b=MX3(b,C1[r+2],C1[r+3]);} \
      float rm=__builtin_fmaxf(a,b); { auto rr=__builtin_amdgcn_permlane32_swap(__float_as_uint(rm),__float_as_uint(rm),false,false); rm=__builtin_fmaxf(__uint_as_float(rr[0]),__uint_as_float(rr[1])); } \
      resc=false; \
      if(__builtin_expect(__any(rm>(float)THRL),0)){ const float dl=__builtin_ceilf(__builtin_fmaxf(rm,0.f)); mhat+=dl; \
        _Pragma("unroll") for(int r=0;r<16;++r){C0[r]-=dl;C1[r]-=dl;} \
        SETM(); \
        const float f=__builtin_amdgcn_exp2f(-dl); l_reg*=f; if(hi==0)wsf[r32]=f; resc=true; } } \
    SBAR(); \
    GAPB2(o[0]=__builtin_amdgcn_mfma_f32_32x32x16_bf16(PAF(0),VFR(0),o[0],0,0,0), C0,0); VRD(0,0,2); SBAR(); \
    GAPB2(o[1]=__builtin_amdgcn_mfma_f32_32x32x16_bf16(PAF(0),VFR(1),o[1],0,0,0), C0,2); VRD(1,1,2); SBAR(); \
    GAPB2(o[2]=__builtin_amdgcn_mfma_f32_32x32x16_bf16(PAF(0),VFR(2),o[2],0,0,0), C0,4); VRD(2,2,2); SBAR(); \
    GAPB2(o[3]=__builtin_amdgcn_mfma_f32_32x32x16_bf16(PAF(0),VFR(3),o[3],0,0,0), C0,6); VRD(3,3,2); SBAR(); \
    GAPB2(o[0]=__builtin_amdgcn_mfma_f32_32x32x16_bf16(PAF(1),VFR(4),o[0],0,0,0), C0,8); VRD(4,0,3); SBAR(); \
    GAPB2(o[1]=__builtin_amdgcn_mfma_f32_32x32x16_bf16(PAF(1),VFR(5),o[1],0,0,0), C0,10); VRD(5,1,3); SBAR(); \
    GAPB2(o[2]=__builtin_amdgcn_mfma_f32_32x32x16_bf16(PAF(1),VFR(6),o[2],0,0,0), C0,12); VRD(6,2,3); SBAR(); \
    GAPB2(o[3]=__builtin_amdgcn_mfma_f32_32x32x16_bf16(PAF(1),VFR(7),o[3],0,0,0), C0,14); VRD(7,3,3); SBAR(); \
    KRD(GL,0); GAPB2(o[0]=__builtin_amdgcn_mfma_f32_32x32x16_bf16(PAF(2),VFR(0),o[0],0,0,0), C1,0); \
    KRD(GL,1); GAPB2(o[1]=__builtin_amdgcn_mfma_f32_32x32x16_bf16(PAF(2),VFR(1),o[1],0,0,0), C1,2); \
    KRD(GL,2); GAPB2(o[2]=__builtin_amdgcn_mfma_f32_32x32x16_bf16(PAF(2),VFR(2),o[2],0,0,0), C1,4); \
    KRD(GL,3); GAPB2(o[3]=__builtin_amdgcn_mfma_f32_32x32x16_bf16(PAF(2),VFR(3),o[3],0,0,0), C1,6); \
    GAPB2(o[0]=__builtin_amdgcn_mfma_f32_32x32x16_bf16(PAF(3),VFR(4),o[0],0,0,0), C1,8); \
    GAPB2(o[1]=__builtin_amdgcn_mfma_f32_32x32x16_bf16(PAF(3),VFR(5),o[1],0,0,0), C1,10); \
    GAPB2(o[2]=__builtin_amdgcn_mfma_f32_32x32x16_bf16(PAF(3),VFR(6),o[2],0,0,0), C1,12); \
    GAPB2(o[3]=__builtin_amdgcn_mfma_f32_32x32x16_bf16(PAF(3),VFR(7),o[3],0,0,0), C1,14); \
    }while(0)
  int t=1;
  #undef CMASK
  #define CMASK(P0,P1,t) do{}while(0)
  for(;t+5<NT;t+=2){
    STEP(pB0,pB1,pA0,pA1,t,true,true,true);     WAIT_BAR(3); RESC(); ROT();
    STEP(pA0,pA1,pB0,pB1,t+1,true,true,true);   WAIT_BAR(3); RESC(); ROT();
  }
  #undef CMASK
  #define CMASK(P0,P1,t) do{int jb_=(t)-(NT-4); if(jb_>=0)cmask(P0,P1,jb_,qrel,hi);}while(0)
  #define ENDW(tt) do{ if((tt)+3<NT){WAIT_BAR(3);} else if((tt)+2<NT){WAIT_BAR(2);} else {WAIT_BAR(0);} }while(0)
  for(;t+1<NT;t+=2){
    STEP(pB0,pB1,pA0,pA1,t,(t+3<NT),(t+1<NT),(t+1<NT));       ENDW(t);   RESC(); ROT();
    STEP(pA0,pA1,pB0,pB1,t+1,(t+4<NT),(t+2<NT),(t+2<NT));     ENDW(t+1); RESC(); ROT();
  }
  STEP(pB0,pB1,pA0,pA1,NT-1,false,false,false); RESC();
  { float sacc=pB0[0]+pB0[1]; _Pragma("unroll") for(int r=2;r<16;++r)sacc+=pB0[r]; _Pragma("unroll") for(int r=0;r<16;++r)sacc+=pB1[r]; l_reg+=sacc;
    pw0=(u32x4){PKW(pB0,0),PKW(pB0,2),PKW(pB0,4),PKW(pB0,6)};pw1=(u32x4){PKW(pB0,8),PKW(pB0,10),PKW(pB0,12),PKW(pB0,14)};pw2=(u32x4){PKW(pB1,0),PKW(pB1,2),PKW(pB1,4),PKW(pB1,6)};pw3=(u32x4){PKW(pB1,8),PKW(pB1,10),PKW(pB1,12),PKW(pB1,14)};
    SBAR(); pv(o,vb0+2*sl_cur,PAF(0),PAF(1),PAF(2),PAF(3)); }
  #undef PKW
  #undef PAF
  #undef VFR
  #undef PIN
  #undef MX3
  #undef GAPA
  #undef GAPB
  #undef GAPB2
  #undef EX
  #undef VRD
  #undef KRD
  #undef STEP
  #undef ENDW
  {auto rr=__builtin_amdgcn_permlane32_swap(__float_as_uint(l_reg),__float_as_uint(l_reg),false,false);l_reg=__uint_as_float(rr[0])+__uint_as_float(rr[1]);}
  if(hi==0)wsf[32+r32]=l_reg;asm volatile("s_waitcnt lgkmcnt(0)":::"memory");
  float rli[16];
  #pragma unroll
  for(int r=0;r<16;++r)rli[r]=__builtin_amdgcn_rcpf(wsf[32+crow(r,hi)]);
  bf16*Ow=O+(rowbase+q0+wid*QBLK)*OP;
  { bf16*stg=(bf16*)(shm+LDS_OST)+wid*4096;
    #pragma unroll
    for(int r=0;r<16;++r){const int orow=crow(r,hi);
      #pragma unroll
      for(int d0=0;d0<4;++d0)stg[orow*128+d0*32+r32]=__float2bfloat16(o[d0][r]*rli[r]);}
    asm volatile("s_waitcnt lgkmcnt(0)":::"memory");
    if(F_fmode==1){
      const __amdgpu_buffer_rsrc_t orr=__builtin_amdgcn_make_buffer_rsrc((void*)Ow,0,0x7fffffff,0x00020000);
      #pragma unroll
      for(int i=0;i<8;++i){const int row=i*4+(lane>>4),ch=lane&15; const u32x4 v=*(const u32x4*)(stg+row*128+ch*8); __builtin_amdgcn_raw_buffer_store_b128(v,orr,(unsigned)((row*OP+ch*8)*2),0,16);}
      asm volatile("s_waitcnt vmcnt(0) lgkmcnt(0)\n\ts_barrier":::"memory");
      if(tid==0)__hip_atomic_store(F_flag,1u,__ATOMIC_RELAXED,__HIP_MEMORY_SCOPE_AGENT);
    } else {
      if(tid==0){ unsigned sp_=0; while(__hip_atomic_load(F_flag,__ATOMIC_RELAXED,__HIP_MEMORY_SCOPE_AGENT)==0u){ __builtin_amdgcn_s_sleep(2); if(++sp_>(1u<<22))break; }
        __builtin_amdgcn_fence(__ATOMIC_ACQUIRE,"agent"); asm volatile("s_waitcnt vmcnt(0)":::"memory"); }
      asm volatile("s_waitcnt lgkmcnt(0)\n\ts_barrier":::"memory");
      const int ch=lane&15; const float*sgp=F_sg+8*ch; const float gs=F_gscale,lam=F_lam;
      const f32x4_t g0=*(const f32x4_t*)sgp*gs,g1=*(const f32x4_t*)(sgp+4)*gs;
      unsigned short*mo=F_mixo+(rowbase+q0+wid*QBLK)*1024;
      u32x4 pv_[8];
      #pragma unroll
      for(int i=0;i<8;++i){const int row=i*4+(lane>>4); pv_[i]=*(const u32x4*)(Ow+(long)row*OP+ch*8);}
      #pragma unroll
      for(int i=0;i<8;++i){const int row=i*4+(lane>>4); const u32x4 a=*(const u32x4*)(stg+row*128+ch*8),c=pv_[i];
        #define BLO(w) __uint_as_float((w)<<16)
        #define BHI(w) __uint_as_float((w)&0xffff0000u)
        const f32x4_t v0=(f32x4_t){BLO(a.x),BHI(a.x),BLO(a.y),BHI(a.y)}-lam*(f32x4_t){BLO(c.x),BHI(c.x),BLO(c.y),BHI(c.y)};
        const f32x4_t v1=(f32x4_t){BLO(a.z),BHI(a.z),BLO(a.w),BHI(a.w)}-lam*(f32x4_t){BLO(c.z),BHI(c.z),BLO(c.w),BHI(c.w)};
        #undef BLO
        #undef BHI
        float sq=(v0[0]*v0[0]+v0[1]*v0[1])+(v0[2]*v0[2]+v0[3]*v0[3])+(v1[0]*v1[0]+v1[1]*v1[1])+(v1[2]*v1[2]+v1[3]*v1[3]);
        #pragma unroll
        for(int m_=1;m_<16;m_<<=1) sq+=__builtin_bit_cast(float,__builtin_amdgcn_ds_bpermute((lane^m_)<<2,__builtin_bit_cast(int,sq)));
        const float rstd=__builtin_amdgcn_rsqf(sq*(1.0f/128.0f)+1e-5f);
        const f32x4_t o0=v0*rstd*g0,o1=v1*rstd*g1;
        u32x4 w; w.x=cvtpk_s(o0[0],o0[1]); w.y=cvtpk_s(o0[2],o0[3]); w.z=cvtpk_s(o1[0],o1[1]); w.w=cvtpk_s(o1[2],o1[3]);
        *(u32x4*)(mo+(long)row*1024+ch*8)=w; }
      asm volatile("s_waitcnt lgkmcnt(0)\n\ts_barrier":::"memory");
    } }
  #undef DMA_K
  #undef TRB
  #undef SETM
  #undef KBIAS
  #undef BIASC
  #undef DMA_V
  #undef CMASK
  #undef START
  #undef RESC
  #undef ROT
}
constexpr int ATTN_LDS_BYTES=LDS_BYTES;
#undef SBAR
#undef WAIT_BAR
}

namespace sgu {
constexpr int SP = 136;
constexpr int HALF_LDS = 128 * SP * 2 + 512;
__device__ __forceinline__ void unit2(LAS unsigned char* lds, const bf16_t* z, bf16_t* mix, const float* ln_g, const float* ln_b, const float* w_s, const float* b_s, int itA, int itB) {
    int tid_ = threadIdx.x; asm volatile("" : "+v"(tid_));
    const int tid = tid_, lane = tid & 63, r32 = lane & 31, hi = lane >> 5; const int wid = __builtin_amdgcn_readfirstlane(tid >> 6);
    const int half = wid >> 2, tl = tid & 255, tb = wid & 3;
    const int it = half ? itB : itA; const bool act = it >= 0;
    const int chunk = act ? it >> 2 : 0, g = act ? it & 3 : 0;
    const size_t row0 = (size_t)chunk * 128;
    LAS bf16_t* Vt = (LAS bf16_t*)(lds + half * HALF_LDS);
    const int t = 32 * tb + r32, nks = 2 * tb + 2;
    const float* wrow = w_s + ((size_t)g * 128 + t) * 128 + 8 * hi;
    f32x4 wa[8], wb[8];
#pragma unroll
    for (int ks = 0; ks < 8; ++ks) { if (act && ks < nks) { wa[ks] = *(const f32x4*)(wrow + 16 * ks); wb[ks] = *(const f32x4*)(wrow + 16 * ks + 4); } else { wa[ks] = (f32x4){0.f, 0.f, 0.f, 0.f}; wb[ks] = wa[ks]; } }
    const float bias = b_s[g * 128 + t];
    const bf16_t* up = z + (row0 + t) * DIN + 1536 + g * 128 + 4 * hi; bf16_t* op = mix + (row0 + t) * D + 512 + g * 128 + 4 * hi;
    if (act) {
        const int s = tl >> 1, qd = tl & 1; const bf16_t* src = z + (row0 + s) * DIN + 2048 + g * 128 + 64 * qd;
        float v[64]; float sum = 0.f;
#pragma unroll
        for (int j = 0; j < 8; ++j) { const u32x4 w = *(const u32x4*)(src + 8 * j);
#pragma unroll
            for (int e = 0; e < 4; ++e) { const float a = gelu_t(bflo(w[e])), c = gelu_t(bfhi(w[e])); v[8 * j + 2 * e] = a; v[8 * j + 2 * e + 1] = c; sum += a + c; } }
        sum += shx(sum, 1, lane);
        const float mean = sum * (1.0f / 128.0f); float sq = 0.f;
#pragma unroll
        for (int j = 0; j < 64; ++j) { v[j] -= mean; sq += v[j] * v[j]; }
        sq += shx(sq, 1, lane);
        const float rstd = __builtin_amdgcn_rsqf(sq * (1.0f / 128.0f) + LN_EPS);
        const float* gp = ln_g + g * 128 + 64 * qd; const float* bp = ln_b + g * 128 + 64 * qd;
#pragma unroll
        for (int j = 0; j < 64; ++j) Vt[(64 * qd + j) * SP + s] = (bf16_t)f2bf(v[j] * rstd * gp[j] + bp[j]);
    }
    __syncthreads();
    if (act) {
        f32x16 acc[4]; acc[0] = f32x16{}; acc[1] = f32x16{}; acc[2] = f32x16{}; acc[3] = f32x16{};
#pragma unroll
        for (int ks = 0; ks < 8; ++ks) if (ks < nks) {
            const int s0 = 16 * ks + 8 * hi;
            u32x4 w; w.x = pk2(s0 <= t ? wa[ks][0] : 0.f, s0 + 1 <= t ? wa[ks][1] : 0.f); w.y = pk2(s0 + 2 <= t ? wa[ks][2] : 0.f, s0 + 3 <= t ? wa[ks][3] : 0.f);
            w.z = pk2(s0 + 4 <= t ? wb[ks][0] : 0.f, s0 + 5 <= t ? wb[ks][1] : 0.f); w.w = pk2(s0 + 6 <= t ? wb[ks][2] : 0.f, s0 + 7 <= t ? wb[ks][3] : 0.f);
            const bf16x8 bfrag = __builtin_bit_cast(bf16x8, w);
#pragma unroll
            for (int cc = 0; cc < 4; ++cc) { const bf16x8 af = *(const LAS bf16x8*)(Vt + (32 * cc + r32) * SP + 16 * ks + 8 * hi);
                acc[cc] = __builtin_amdgcn_mfma_f32_32x32x16_bf16(af, bfrag, acc[cc], 0, 0, 0); }
        }
#pragma unroll
        for (int cc = 0; cc < 4; ++cc) {
            u32x2 uw[4];
#pragma unroll
            for (int q4 = 0; q4 < 4; ++q4) uw[q4] = *(const u32x2*)(up + 32 * cc + 8 * q4);
#pragma unroll
            for (int q4 = 0; q4 < 4; ++q4) { const u32x2 u2 = uw[q4];
                const float o0 = gelu_t(bflo(u2.x)) * (acc[cc][4 * q4] + bias), o1 = gelu_t(bfhi(u2.x)) * (acc[cc][4 * q4 + 1] + bias);
                const float o2 = gelu_t(bflo(u2.y)) * (acc[cc][4 * q4 + 2] + bias), o3 = gelu_t(bfhi(u2.y)) * (acc[cc][4 * q4 + 3] + bias);
                u32x2 w; w.x = cvtpk(o0, o1); w.y = cvtpk(o2, o3); *(u32x2*)(op + 32 * cc + 8 * q4) = w; }
        }
    }
    __syncthreads();
}
constexpr int QUARTER_LDS = 128 * SP * 2 + 512;
__device__ __forceinline__ void unit4(LAS unsigned char* lds, const bf16_t* z, bf16_t* mix, const float* ln_g, const float* ln_b, const float* w_s, const float* b_s, int it0, int it1, int it2, int it3) {
    int tid_ = threadIdx.x; asm volatile("" : "+v"(tid_));
    const int tid = tid_, lane = tid & 63, r32 = lane & 31, hi = lane >> 5; const int wid = __builtin_amdgcn_readfirstlane(tid >> 6);
    const int qt = wid >> 1, wq = wid & 1, tq = tid & 127;
    const int it = qt == 0 ? it0 : qt == 1 ? it1 : qt == 2 ? it2 : it3; const bool act = it >= 0;
    const int chunk = act ? it >> 2 : 0, g = act ? it & 3 : 0;
    const size_t row0 = (size_t)chunk * 128;
    LAS bf16_t* Vt = (LAS bf16_t*)(lds + qt * QUARTER_LDS);
    if (act) {
        const bf16_t* src = z + (row0 + tq) * DIN + 2048 + g * 128;
        unsigned vp[64]; float sum = 0.f, sq = 0.f;
#pragma unroll
        for (int j = 0; j < 16; ++j) { const u32x4 w = *(const u32x4*)(src + 8 * j);
#pragma unroll
            for (int e = 0; e < 4; ++e) { const f32x2 gv = gelu_t2((f32x2){bflo(w[e]), bfhi(w[e])}); vp[4 * j + e] = cvtpk(gv.x, gv.y); sum += gv.x + gv.y; sq += gv.x * gv.x + gv.y * gv.y; } }
        const float mean = sum * (1.0f / 128.0f);
        const float rstd = __builtin_amdgcn_rsqf(fmaxf(sq * (1.0f / 128.0f) - mean * mean, 0.f) + LN_EPS);
        const float* gp = ln_g + g * 128; const float* bp = ln_b + g * 128;
#pragma unroll
        for (int j = 0; j < 64; ++j) { const f32x2 nv = (((f32x2){bflo(vp[j]), bfhi(vp[j])} - mean) * rstd) * (f32x2){gp[2 * j], gp[2 * j + 1]} + (f32x2){bp[2 * j], bp[2 * j + 1]};
            const unsigned w = cvtpk(nv.x, nv.y);
            Vt[(2 * j) * SP + tq] = (bf16_t)(w & 0xffffu); Vt[(2 * j + 1) * SP + tq] = (bf16_t)(w >> 16); }
    }
    __syncthreads();
    if (act) {
#pragma unroll
        for (int pass = 0; pass < 2; ++pass) {
            const int tb = pass == 0 ? (wq ? 1 : 0) : (wq ? 2 : 3); const int t = 32 * tb + r32, nks = 2 * tb + 2;
            const float* wrow = w_s + ((size_t)g * 128 + t) * 128 + 8 * hi;
            f32x4 wa[8], wb[8];
#pragma unroll
            for (int ks = 0; ks < 8; ++ks) { if (ks < nks) { wa[ks] = *(const f32x4*)(wrow + 16 * ks); wb[ks] = *(const f32x4*)(wrow + 16 * ks + 4); } else { wa[ks] = (f32x4){0.f, 0.f, 0.f, 0.f}; wb[ks] = wa[ks]; } }
            const float bias = b_s[g * 128 + t];
            const bf16_t* up = z + (row0 + t) * DIN + 1536 + g * 128 + 4 * hi; bf16_t* op = mix + (row0 + t) * D + 512 + g * 128 + 4 * hi;
            u32x2 uw[16];
#pragma unroll
            for (int j = 0; j < 16; ++j) uw[j] = *(const u32x2*)(up + 8 * j);
            f32x16 acc[4]; acc[0] = f32x16{}; acc[1] = f32x16{}; acc[2] = f32x16{}; acc[3] = f32x16{};
#pragma unroll
            for (int ks = 0; ks < 8; ++ks) if (ks < nks) {
                const int s0 = 16 * ks + 8 * hi;
                u32x4 w; w.x = pk2(s0 <= t ? wa[ks][0] : 0.f, s0 + 1 <= t ? wa[ks][1] : 0.f); w.y = pk2(s0 + 2 <= t ? wa[ks][2] : 0.f, s0 + 3 <= t ? wa[ks][3] : 0.f);
                w.z = pk2(s0 + 4 <= t ? wb[ks][0] : 0.f, s0 + 5 <= t ? wb[ks][1] : 0.f); w.w = pk2(s0 + 6 <= t ? wb[ks][2] : 0.f, s0 + 7 <= t ? wb[ks][3] : 0.f);
                const bf16x8 bfrag = __builtin_bit_cast(bf16x8, w);
#pragma unroll
                for (int cc = 0; cc < 4; ++cc) { const bf16x8 af = *(const LAS bf16x8*)(Vt + (32 * cc + r32) * SP + 16 * ks + 8 * hi);
                    acc[cc] = __builtin_amdgcn_mfma_f32_32x32x16_bf16(af, bfrag, acc[cc], 0, 0, 0); }
            }
#pragma unroll
            for (int cc = 0; cc < 4; ++cc)
#pragma unroll
                for (int q4 = 0; q4 < 4; ++q4) { const u32x2 u2 = uw[4 * cc + q4];
                    const f32x2 oa = gelu_t2((f32x2){bflo(u2.x), bfhi(u2.x)}) * ((f32x2){acc[cc][4 * q4], acc[cc][4 * q4 + 1]} + bias);
                    const f32x2 ob = gelu_t2((f32x2){bflo(u2.y), bfhi(u2.y)}) * ((f32x2){acc[cc][4 * q4 + 2], acc[cc][4 * q4 + 3]} + bias);
                    u32x2 w; w.x = cvtpk(oa.x, oa.y); w.y = cvtpk(ob.x, ob.y); *(u32x2*)(op + 32 * cc + 8 * q4) = w; }
        }
    }
    __syncthreads();
}
}
constexpr int CV_IN = (D / 64) * (DIN / 32), CV_OUT = (D / 64) * (D / 32), CV_UP = (D / 64) * (NUP / 32), CV_DN = (DFF / 64) * (D / 32), CV_L = CV_IN + CV_OUT + CV_UP + CV_DN;
struct CvPtrs { const float *w_in, *norm1_g, *w_out, *w_up, *norm2_g, *w_down; };
__device__ __forceinline__ void cv_desc(int gi, const float* w_in, const float* norm1_g, const float* w_out, const float* w_up, const float* norm2_g, const float* w_down, unsigned char* ws,
                                        const float*& W, const float*& gk, bf16_t*& WT, int& K, int& N, int& k0, int& n0, int& mode) {
    const int l = gi / CV_L; int r = gi % CV_L; unsigned char* wl = ws + WS_W + l * W_LAYER;
    if (r < CV_IN) { W = w_in + (size_t)l * D * DIN; gk = norm1_g + l * D; WT = (bf16_t*)(wl + W_IN); K = D; N = DIN; mode = 1; }
    else if ((r -= CV_IN) < CV_OUT) { W = w_out + (size_t)l * D * D; gk = nullptr; WT = (bf16_t*)(wl + W_OUT); K = D; N = D; mode = 0; }
    else if ((r -= CV_OUT) < CV_UP) { W = w_up + (size_t)l * D * NUP; gk = norm2_g + l * D; WT = (bf16_t*)(wl + W_UP); K = D; N = NUP; mode = 2; }
    else { r -= CV_UP; W = w_down + (size_t)l * DFF * D; gk = nullptr; WT = (bf16_t*)(wl + W_DOWN); K = DFF; N = D; mode = 0; }
    const int nblk = N / 32; k0 = 64 * (r / nblk); n0 = 32 * (r % nblk);
}
__device__ __forceinline__ void cv_load(float (&wv)[32], const float* W, int N, int k0, int n0, int lane) {
#pragma unroll
    for (int i = 0; i < 32; ++i) wv[i] = __builtin_nontemporal_load(W + (size_t)(k0 + 2 * i + (lane >> 5)) * N + n0 + (lane & 31));
}
__device__ __forceinline__ void cv_finish(const float (&wv)[32], const float* gk, bf16_t* WT, int K, int k0, int n0, int mode, LAS float* scr, int lane) {
    const float cs = (mode == 1 && n0 < 512) ? QSCALE : 1.0f;
#pragma unroll
    for (int i = 0; i < 32; ++i) { const int kk = 2 * i + (lane >> 5); float v = wv[i];
        if (mode != 0) v *= gk[k0 + kk] * cs;
        scr[kk * 33 + (lane & 31)] = v; }
    asm volatile("s_waitcnt lgkmcnt(0)" ::: "memory");
    const int c = lane & 7;
    int d0 = n0;
    if (mode == 2) { const int half = n0 >= DFF ? 1 : 0, cc = n0 - half * DFF; d0 = 256 * (cc >> 7) + 128 * half + (cc & 127); }
#pragma unroll
    for (int j = 0; j < 4; ++j) { const int n = (lane >> 3) + 8 * j; const LAS float* s = scr + (8 * c) * 33 + n;
        u32x4 o; o.x = pk2(s[0 * 33], s[1 * 33]); o.y = pk2(s[2 * 33], s[3 * 33]); o.z = pk2(s[4 * 33], s[5 * 33]); o.w = pk2(s[6 * 33], s[7 * 33]);
        *(u32x4*)(WT + (size_t)(d0 + n) * K + k0 + 8 * c) = o; }
    asm volatile("s_waitcnt lgkmcnt(0)" ::: "memory");
}
__device__ __forceinline__ void convert_weights(const float* w_in, const float* norm1_g, const float* w_out, const float* w_up, const float* norm2_g, const float* w_down, unsigned char* ws, LAS float* scr, int lane, int first, int stride, int total) {
    if (first >= total) return;
    const float *W, *gk; bf16_t* WT; int K, N, k0, n0, mode; float wv[32];
    cv_desc(first, w_in, norm1_g, w_out, w_up, norm2_g, w_down, ws, W, gk, WT, K, N, k0, n0, mode);
    cv_load(wv, W, N, k0, n0, lane);
    for (int gi = first;;) {
        const int g2 = gi + stride; const bool has = g2 < total;
        const float *W2 = W, *gk2 = gk; bf16_t* WT2 = WT; int K2 = K, N2 = N, k02 = k0, n02 = n0, mode2 = mode; float wv2[32];
        if (has) { cv_desc(g2, w_in, norm1_g, w_out, w_up, norm2_g, w_down, ws, W2, gk2, WT2, K2, N2, k02, n02, mode2); cv_load(wv2, W2, N2, k02, n02, lane); }
        cv_finish(wv, gk, WT, K, k0, n0, mode, scr, lane);
        if (!has) break;
        W = W2; gk = gk2; WT = WT2; K = K2; N = N2; k0 = k02; n0 = n02; mode = mode2; gi = g2;
#pragma unroll
        for (int i = 0; i < 32; ++i) wv[i] = wv2[i];
    }
}

#define XB_TMO      128
#define XB_XCNT(j)  (256  + 64 * (j))
#define XB_XSUB(j)  (1280 + 64 * (j))
#define XB_XGEN(j)  (2304 + 64 * (j))
#define XB_TOP      3328
#define XB_TOPGEN   3392
#define XCD_BAR_WORDS 3456
#define XB_SPIN_CAP (1u << 18)

__device__ __forceinline__ unsigned xb_ld(unsigned* p)              { return __hip_atomic_load(p, __ATOMIC_RELAXED, __HIP_MEMORY_SCOPE_AGENT); }
__device__ __forceinline__ unsigned xb_add(unsigned* p, unsigned v) { return __hip_atomic_fetch_add(p, v, __ATOMIC_RELAXED, __HIP_MEMORY_SCOPE_AGENT); }
__device__ __forceinline__ unsigned xb_xcc_id() { return (unsigned)__builtin_amdgcn_s_getreg((3 << 11) | 20) & 0xFu; }
#define XB_SPIN(cond, bar) do { unsigned _sp = 0; while (cond) { __builtin_amdgcn_s_sleep(1); \
    if ((++_sp & 255u) == 0u) { if (xb_ld(&(bar)[XB_TMO])) break; if (_sp > XB_SPIN_CAP) { atomicAdd(&(bar)[XB_TMO], 1u); break; } } } } while (0)

struct XcdBarrier {
    unsigned* bar; unsigned x;
    volatile LAS unsigned* st;
};

__device__ __forceinline__ XcdBarrier xcd_barrier_post(unsigned* bar, volatile LAS unsigned* st) {
    XcdBarrier b; b.bar = bar; b.x = xb_xcc_id(); b.st = st;
    if (threadIdx.x == 0) (void)xb_add(&bar[XB_XCNT(b.x)], 1u);
    return b;
}
__device__ __forceinline__ void xcd_barrier_complete(unsigned* bar, unsigned x, unsigned& nloc, unsigned& nx) {
    const unsigned G = gridDim.x * gridDim.y * gridDim.z;
    unsigned sum, cnt, mine, sp = 0u;
    for (;;) {
        sum = 0u; cnt = 0u; mine = 0u;
#pragma unroll
        for (unsigned j = 0; j < 16; ++j) { const unsigned c = xb_ld(&bar[XB_XCNT(j)]); sum += c; cnt += (c > 0u) ? 1u : 0u; mine = (j == x) ? c : mine; }
        if (sum == G) break;
        __builtin_amdgcn_s_sleep(1);
        if ((++sp & 255u) == 0u) { if (xb_ld(&bar[XB_TMO])) break; if (sp > XB_SPIN_CAP) { atomicAdd(&bar[XB_TMO], 1u); break; } }
    }
    nloc = mine > 0u ? mine : 1u; nx = cnt > 0u ? cnt : 1u;
}

__device__ __forceinline__ void xcd_barrier(const XcdBarrier& b) {
    asm volatile("s_waitcnt vmcnt(0)" ::: "memory");
    __syncthreads();
    if (threadIdx.x == 0) {
        unsigned* bar = b.bar;
        __builtin_amdgcn_s_waitcnt(0);
        unsigned nloc = b.st[0], nx = b.st[1];
        if (nloc == 0u) { xcd_barrier_complete(bar, b.x, nloc, nx); b.st[0] = nloc; b.st[1] = nx; }
        const unsigned old = xb_add(&bar[XB_XSUB(b.x)], 1u);
        const unsigned gen = old / nloc;
        if (old + 1u == (gen + 1u) * nloc) {
            __builtin_amdgcn_fence(__ATOMIC_RELEASE, "agent");
            asm volatile("s_waitcnt vmcnt(0)" ::: "memory");
            const unsigned og = xb_add(&bar[XB_TOP], 1u);
            const unsigned tg = og / nx;
            if (og + 1u == (tg + 1u) * nx) xb_add(&bar[XB_TOPGEN], 1u);
            else XB_SPIN(xb_ld(&bar[XB_TOPGEN]) == tg, bar);
            __builtin_amdgcn_fence(__ATOMIC_ACQUIRE, "agent");
            xb_add(&bar[XB_XGEN(b.x)], 1u);
            asm volatile("s_waitcnt vmcnt(0)" ::: "memory");
        } else {
            XB_SPIN(xb_ld(&bar[XB_XGEN(b.x)]) == gen, bar);
            __builtin_amdgcn_fence(__ATOMIC_ACQUIRE, "agent");
            asm volatile("s_waitcnt vmcnt(0)" ::: "memory");
        }
    }
    __syncthreads();
}

struct Params {
    const float *x, *norm1_g, *w_in, *lam_q1, *lam_k1, *lam_q2, *lam_k2, *subln_g, *sgu_ln_g, *sgu_ln_b, *sgu_w, *sgu_b, *w_out, *norm2_g, *ffn_w_up, *ffn_conv_w, *ffn_conv_b, *ffn_w_down, *final_g;
    float* out; unsigned char* ws;
};

#define CAS __attribute__((address_space(4)))
#define LOADP() const CAS Params* pp = (const CAS Params*)__builtin_amdgcn_kernarg_segment_ptr(); asm volatile("" : "+s"(pp)); unsigned char* ws = pp->ws; float* ss = (float*)(ws + WS_SS)
#define GRID_BAR() do { const CAS Params* ppb = (const CAS Params*)__builtin_amdgcn_kernarg_segment_ptr(); asm volatile("" : "+s"(ppb)); XcdBarrier b_; b_.bar = (unsigned*)(ppb->ws + WS_CTL); b_.x = xb_xcc_id(); \
        b_.st = (volatile LAS unsigned*)((LAS unsigned char*)lds_raw + LDS_BYTES - 64); xcd_barrier(b_); } while (0)

template <int l> __device__ __forceinline__ void layer_body(LAS unsigned char* lds, unsigned char* lds_raw, const int G, const int bx, const int vcu) {
#if PH & 1
        {
            LOADP(); unsigned char* wl = ws + WS_W + l * W_LAYER;
            pg8::Gemm g{(const bf16_t*)(ws + WS_XB), (const bf16_t*)(wl + W_IN), M, DIN, D, 256, 128, 0};
            int Gl = G, bxl = bx; asm volatile("" : "+s"(Gl), "+s"(bxl));
            const bool fused = FUSE_SGU && (Gl == 256);
            unsigned* cnt = (unsigned*)(ws + WS_CTL) + 8192 + 64 * l;
            InProjOrder S; S.init(G, bx, cnt, fused);
            fill_rstd<false>(lds, S, ss);
            EpiInProj E{(bf16_t*)(ws + WS_Z), (LAS const float*)(lds + RSTAB_OFF), fused};
            for (int rep = 0; rep < REP_P1; ++rep) pg8::gemm_phase<EpiInProj, InProjOrder, true, true>(lds, g, S, E);
            if (fused && bxl >= 128) {
                if (threadIdx.x == 0) { unsigned sp = 0;
                    while (__hip_atomic_load(cnt, __ATOMIC_RELAXED, __HIP_MEMORY_SCOPE_AGENT) < 256u * REP_P1) { __builtin_amdgcn_s_sleep(2); if (++sp > (1u << 22)) break; }
                    __builtin_amdgcn_fence(__ATOMIC_ACQUIRE, "agent"); asm volatile("s_waitcnt vmcnt(0)" ::: "memory"); }
                __syncthreads();
                const bf16_t* zb = (const bf16_t*)(ws + WS_Z); bf16_t* mix = (bf16_t*)(ws + WS_MIX);
                { const int it = bxl - 128; sgu::unit4(lds, zb, mix, pp->sgu_ln_g + l * 512, pp->sgu_ln_b + l * 512, pp->sgu_w + (size_t)l * 4 * 128 * 128, pp->sgu_b + l * 512, it, it + 128, it + 256, it + 384); }
            }
        }
        GRID_BAR();
#endif
#if PH & 2
        {
            LOADP(); (void)ss; int tid = threadIdx.x; asm volatile("" : "+v"(tid)); const int lane = tid & 63;
            const attn_body::bf16* z = (const attn_body::bf16*)(ws + WS_Z); attn_body::bf16* opart = (attn_body::bf16*)(ws + WS_OP1);
            const int bhr = vcu >> 4, s16 = vcu & 15, b = bhr >> 3, h = (bhr >> 1) & 3, br = bhr & 1;
            const float slope2 = exp2f(-2.0f * (float)(h + 1)) * LOG2E;
            const float lam_init = 0.8f - 0.6f * expf(-0.3f * (float)l);
            const float d1 = wave_sum(pp->lam_q1[l * 64 + lane] * pp->lam_k1[l * 64 + lane], lane), d2 = wave_sum(pp->lam_q2[l * 64 + lane] * pp->lam_k2[l * 64 + lane], lane);
            const float lam = __builtin_bit_cast(float, __builtin_amdgcn_readfirstlane(__builtin_bit_cast(int, expf(d1) - expf(d2) + lam_init)));
            unsigned* flags = (unsigned*)(ws + WS_CTL) + 9216 + ((l * 8 + b * 4 + h) * 32) * 16;
            if (vcu < 256)
                for (int i = 0; i < 2 * REP_ATT; ++i) { const int qb = (i & 1) ? 31 - s16 : s16;
                    attn_body::attn_unit<8>(b, qb, z + h * 128 + br * 64, z + 512 + h * 128 + br * 64, z + 1024 + h * 128, opart + h * 128, (char*)lds_raw, slope2, br, flags + qb * 16, (unsigned short*)(ws + WS_MIX) + h * 128, lam, 1.0f - lam_init, pp->subln_g + l * 128); }
        }
        GRID_BAR();
#endif
#if PH & 4
        {
            LOADP(); (void)ss;
            const bf16_t* zb = (const bf16_t*)(ws + WS_Z); bf16_t* mix = (bf16_t*)(ws + WS_MIX);
            int Gl = G; asm volatile("" : "+s"(Gl));
            if (!FUSE_SGU || Gl != 256) {
                for (int rs_ = 0; rs_ < REP_SGU * REP_P2B; ++rs_)
                for (int it = vcu; it < 512; it += 2 * G) sgu::unit2(lds, zb, mix, pp->sgu_ln_g + l * 512, pp->sgu_ln_b + l * 512, pp->sgu_w + (size_t)l * 4 * 128 * 128, pp->sgu_b + l * 512, it, it + G < 512 ? it + G : -1);
                GRID_BAR();
            }
        }
#endif
#if PH & 8
        {
            LOADP(); unsigned char* wl = ws + WS_W + l * W_LAYER;
            pg8::Gemm g{(const bf16_t*)(ws + WS_MIX), (const bf16_t*)(wl + W_OUT), M, D, D, 256, 128, 0}; pg8::StaticOrder S; S.init(M, D, G, bx);
            EpiRes E{nullptr, (bf16_t*)(ws + WS_XB), ss};
            pg8::gemm_phase<EpiRes, pg8::StaticOrder, true, true>(lds, g, S, E);
        }
        GRID_BAR();
#endif
#if PH & 16
        {
            LOADP(); unsigned char* wl = ws + WS_W + l * W_LAYER;
            pg8::Gemm g{(const bf16_t*)(ws + WS_XB) - 2 * D, (const bf16_t*)(wl + W_UP), P4_TILES * 256, NUP, D, P4_ROWS, P4_ROWS / 2, 2}; pg8::StaticOrder S; S.init(P4_TILES * 256, NUP, G, bx);
            fill_rstd<true>(lds, S, ss);
            EpiConvGate E{(bf16_t*)(ws + WS_Y), (LAS const float*)(lds + RSTAB_OFF), pp->ffn_conv_w + (size_t)l * 3 * NUP, pp->ffn_conv_b + (size_t)l * NUP};
            for (int rep = 0; rep < REP_P4; ++rep) pg8::gemm_phase<EpiConvGate, pg8::StaticOrder, true, true>(lds, g, S, E);
        }
        GRID_BAR();
#endif
#if PH & 32
        {
            LOADP(); unsigned char* wl = ws + WS_W + l * W_LAYER;
            pg8::Gemm g{(const bf16_t*)(ws + WS_Y), (const bf16_t*)(wl + W_DOWN), M, D, DFF, 256, 128, 0}; pg8::StaticOrder S; S.init(M, D, G, bx);
            int Gl = G; asm volatile("" : "+s"(Gl));
            if (l == DEPTH - 1 && Gl == 256) {
                EpiResFinal E{(const bf16_t*)(ws + WS_XB), ss, pp->out, pp->final_g, (unsigned*)(ws + WS_CTL) + 20480, (LAS float*)(lds + RSTAB_OFF)};
                pg8::gemm_phase<EpiResFinal, pg8::StaticOrder, true, true>(lds, g, S, E);
            } else {
                EpiRes E{nullptr, (bf16_t*)(ws + WS_XB), ss};
                pg8::gemm_phase<EpiRes, pg8::StaticOrder, true, true>(lds, g, S, E);
                GRID_BAR();
            }
        }
#endif
}

__global__ void __launch_bounds__(512, 2) fwd_megakernel(Params Punused) {
    extern __shared__ __attribute__((aligned(16))) unsigned char lds_raw[];
    LAS unsigned char* lds = (LAS unsigned char*)lds_raw;
    cg::grid_group grid = cg::this_grid();
    const int G = gridDim.x, bx = blockIdx.x;
    const int vcu = (G % 8 == 0) ? (bx % 8) * (G / 8) + bx / 8 : bx;
    volatile LAS unsigned* bst = (volatile LAS unsigned*)(lds + LDS_BYTES - 64);
    if (threadIdx.x < 2) bst[threadIdx.x] = 0u;
    __syncthreads();
    { const CAS Params* pp0 = (const CAS Params*)__builtin_amdgcn_kernarg_segment_ptr(); (void)xcd_barrier_post((unsigned*)(pp0->ws + WS_CTL), bst); }
    {
        LOADP(); int tid = threadIdx.x; asm volatile("" : "+v"(tid)); const int lane = tid & 63, wave = __builtin_amdgcn_readfirstlane(tid >> 6), gw = vcu * 8 + wave, NGW = G * 8;
        bf16_t* xb = (bf16_t*)(ws + WS_XB);
        LAS float* scr = (LAS float*)(lds + wave * 16384);
        for (int rep = 0; rep < REP_P0; ++rep) {
        convert_weights(pp->w_in, pp->norm1_g, pp->w_out, pp->ffn_w_up, pp->norm2_g, pp->ffn_w_down, ws, scr, lane, gw, NGW, DEPTH * CV_L);
        const float* x = pp->x;
        for (int m0 = gw; m0 < M; m0 += 2 * NGW) {
            f32x4 v[2][4];
#pragma unroll
            for (int k = 0; k < 2; ++k) { const f32x4* xr = (const f32x4*)(x + (size_t)(m0 + k * NGW) * D) + lane;
#pragma unroll
                for (int j = 0; j < 4; ++j) v[k][j] = __builtin_nontemporal_load(xr + 64 * j); }
#pragma unroll
            for (int k = 0; k < 2; ++k) { const int m = m0 + k * NGW; float s = 0.f;
                unsigned long long* o8 = (unsigned long long*)(xb + (size_t)m * D) + lane;
#pragma unroll
                for (int j = 0; j < 4; ++j) { const f32x4 t = v[k][j]; s += (t[0] * t[0] + t[1] * t[1]) + (t[2] * t[2] + t[3] * t[3]);
                    o8[64 * j] = (unsigned long long)pk2(t[0], t[1]) | ((unsigned long long)pk2(t[2], t[3]) << 32); }
                s = wave_sum(s, lane);
                if (lane < 16) ss[(size_t)m * 16 + lane] = lane == 0 ? s : 0.f; }
        }
        }
    }
    if (gridDim.y == 7u) grid.sync();
    GRID_BAR();
    for (int rep = 0; rep < REP_SYNC; ++rep) GRID_BAR();

    layer_body<0>(lds, lds_raw, G, bx, vcu);
    layer_body<1>(lds, lds_raw, G, bx, vcu);
    if (G != 256) {
        LOADP(); int tid = threadIdx.x; asm volatile("" : "+v"(tid)); const int lane = tid & 63, wave = __builtin_amdgcn_readfirstlane(tid >> 6), gw = vcu * 8 + wave, NGW = G * 8;
        float* out = pp->out; const f32x4* gp = (const f32x4*)pp->final_g + lane;
        const bf16_t* xb = (const bf16_t*)(ws + WS_XB);
        f32x4 gv[4];
#pragma unroll
        for (int j = 0; j < 4; ++j) gv[j] = gp[64 * j];
        for (int m0 = gw; m0 < M; m0 += 2 * NGW) {
            u32x2 xv[2][4]; float rs[2];
#pragma unroll
            for (int k = 0; k < 2; ++k) { const int m = m0 + k * NGW; const u32x2* xr = (const u32x2*)(xb + (size_t)m * D) + lane;
#pragma unroll
                for (int j = 0; j < 4; ++j) xv[k][j] = xr[64 * j];
                rs[k] = row_rstd(ss, m, NORM_EPS); }
#pragma unroll
            for (int k = 0; k < 2; ++k) { const int m = m0 + k * NGW; f32x4* xr = (f32x4*)(out + (size_t)m * D) + lane;
#pragma unroll
                for (int j = 0; j < 4; ++j) xr[64 * j] = (f32x4){bflo(xv[k][j].x), bfhi(xv[k][j].x), bflo(xv[k][j].y), bfhi(xv[k][j].y)} * rs[k] * gv[j]; }
        }
    }
}

extern "C" void kernel_launch(void* const* d_in, const int* in_sizes, int n_in, void* d_out, int out_size, void* d_ws, size_t ws_size, hipStream_t stream) {
    static int grid = 0;
    if (grid == 0) {
        if (n_in != 19 || in_sizes[0] != M * D || out_size != M * D || ws_size < WS_END) { fprintf(stderr, "kernel_launch: unexpected shapes (n_in %d, ws %zu)\n", n_in, ws_size); grid = -1; return; }
        int dev = 0, cus = 0, per_cu = 0;
        hipGetDevice(&dev); hipDeviceGetAttribute(&cus, hipDeviceAttributeMultiprocessorCount, dev);
        if (hipFuncSetAttribute((const void*)fwd_megakernel, hipFuncAttributeMaxDynamicSharedMemorySize, LDS_BYTES) != hipSuccess) { fprintf(stderr, "kernel_launch: hipFuncSetAttribute failed\n"); grid = -1; return; }
        if (hipOccupancyMaxActiveBlocksPerMultiprocessor(&per_cu, (const void*)fwd_megakernel, 512, LDS_BYTES) != hipSuccess || per_cu < 1) { fprintf(stderr, "kernel_launch: occupancy query gave %d\n", per_cu); per_cu = 1; }
        (void)hipGetLastError();
        grid = cus;
    }
    if (grid < 0) return;
    if (hipMemsetAsync((char*)d_ws + WS_CTL, 0, CTL_BYTES, stream) != hipSuccess) { fprintf(stderr, "kernel_launch: memset failed\n"); return; }
    Params p{};
    const float** f = (const float**)&p;
    for (int i = 0; i < 19; ++i) f[i] = (const float*)d_in[i];
    p.out = (float*)d_out; p.ws = (unsigned char*)d_ws;
    void* args[] = {&p};
    const hipError_t e = hipLaunchCooperativeKernel((const void*)fwd_megakernel, dim3(grid), dim3(512), args, LDS_BYTES, stream);
    if (e != hipSuccess) fprintf(stderr, "kernel_launch: cooperative launch failed: %s (grid %d)\n", hipGetErrorString(e), grid);
}
```

```cpp
#include <hip/hip_runtime.h>
#include <hip/hip_cooperative_groups.h>
#include <cstdio>
#include <cstdint>
#include <cmath>
#include <hip/hip_bf16.h>
namespace cg = cooperative_groups;
#ifndef REP_ATT
#define REP_ATT 1
#endif
#ifndef REP_P4
#define REP_P4 1
#endif
#ifndef REP_P1
#define REP_P1 1
#endif
#ifndef REP_P2B
#define REP_P2B 1
#endif
#ifndef REP_P0
#define REP_P0 1
#endif
#ifndef REP_SYNC
#define REP_SYNC 0
#endif
#ifndef REP_SGU
#define REP_SGU 1
#endif
#ifndef FUSE_SGU
#define FUSE_SGU 1
#endif
#ifndef PH
#define PH 63
#endif
namespace pg8 {
#define PG8_LAS __attribute__((address_space(3)))
typedef unsigned short bf16_t;
typedef short bf16x8 __attribute__((ext_vector_type(8)));
typedef float f32x4 __attribute__((ext_vector_type(4)));
typedef unsigned u32x4 __attribute__((ext_vector_type(4)));
constexpr int BM = 256, BK = 64, HALF = 128, HTB = HALF * BK * 2  , STAGE_BYTES = 8 * HTB, NXCD = 8, WGM = 8;

__host__ __device__ __forceinline__ int lds_byte(int r, int c) { const int st = (r >> 4) * 2 + (c >> 5), rr = r & 15, cc = c & 31, ob = rr * 64 + cc * 2; return st * 1024 + (ob ^ (((ob >> 9) & 1) << 5)); }
__host__ __device__ __forceinline__ void stage_rc(int b, int& R, int& C) { const int st = b / 1024, sb = b % 1024, swz = sb ^ (((sb >> 9) & 1) << 5); R = (st >> 1) * 16 + swz / 64; C = (st & 1) * 32 + (swz % 64) / 2; }
__host__ __device__ __forceinline__ int perm32(int rho) { const int n = rho >> 4, i = rho & 15; return 8 * (i >> 2) + 4 * n + (i & 3); }

struct Unit { int pm, pn, ui; };
struct Gemm { const bf16_t* A; const bf16_t* Bt; int M, N, K; int a_tile_rows, a_half_rows, a_skip; };

struct StaticOrder {
    int nM, nN, nwg, G, c;
    __host__ __device__ void init(int M, int N, int G_, int c_) { nM = M / BM; nN = N / BM; nwg = nM * nN; G = G_; c = c_; }
    __host__ __device__ bool next(int i, Unit& u) const {
        const long L = (long)i * G + c; if (L >= nwg) return false;
        int wgid = (int)L; { const int q = nwg / NXCD, r = nwg % NXCD, xcd = wgid % NXCD, off = wgid / NXCD; wgid = (xcd < r ? xcd * (q + 1) : r * (q + 1) + (xcd - r) * q) + off; }
        const int nig = WGM * nN, gid = wgid / nig, fm = gid * WGM, gsz = (nM - fm) < WGM ? (nM - fm) : WGM;
        u.pm = fm + ((wgid % nig) % gsz); u.pn = (wgid % nig) / gsz; u.ui = i; return true;
    }
    __device__ __forceinline__ void a_ready(const Unit&) const {}
    __device__ __forceinline__ void done(const Unit&) const {}
};

__device__ __forceinline__ unsigned cvt_pk_bf16(float lo, float hi) { unsigned r; asm volatile("v_cvt_pk_bf16_f32 %0, %1, %2" : "=v"(r) : "v"(lo), "v"(hi)); return r; }
template <class Epi, class Sched, bool ALIGN_EPI = false, bool SP2 = false>
__device__ __forceinline__ void gemm_phase(PG8_LAS unsigned char* lds, const Gemm g, const Sched& S, const Epi& E) {
    int tid_ = threadIdx.x; asm volatile("" : "+v"(tid_));
    const int tid = tid_, wid = __builtin_amdgcn_readfirstlane(tid >> 6), lane = tid & 63, wr = wid >> 2, wc = wid & 3, fr = lane & 15, fq = lane >> 4;
    const int K = g.K, nt = K / BK;
    unsigned voffA[2], voffB[2];
#pragma unroll
    for (int i = 0; i < 2; ++i) { int R, C; stage_rc(tid * 16 + i * 8192, R, C); const int Rb = Epi::PERM ? ((R & ~31) + perm32(R & 31)) : R;
        voffA[i] = (unsigned)((R - g.a_skip * (R >> 6)) * K + C) * 2u; voffB[i] = (unsigned)(Rb * K + C) * 2u; }
    const size_t kstep = (size_t)(BK * 2);
    const size_t hstepB = (size_t)HALF * K * 2, hstepA = (size_t)g.a_half_rows * K * 2;
    const size_t tstepB = 2 * hstepB, tstepA = (size_t)g.a_tile_rows * K * 2;
    const unsigned ldsw = (unsigned)wid * 1024u;
    const int aoff = lds_byte(wr * 64 + fr, fq * 8), boff = lds_byte(wc * 32 + fr, fq * 8);
#define PG8_SA(b, h) (((b) * 2 + (h)) * HTB)
#define PG8_SB(b, h) ((4 + (b) * 2 + (h)) * HTB)
#define PG8_STAGE(bufoff, gbase, voff) do { _Pragma("unroll") for (int _i = 0; _i < 2; ++_i) \
        __builtin_amdgcn_global_load_lds((const unsigned*)((const char*)(gbase) + (voff)[_i]), (PG8_LAS unsigned*)(lds + (bufoff) + ldsw + _i * 8192), 16, 0, 0); } while (0)
#define PG8_LDA(dst, b, h) do { _Pragma("unroll") for (int m = 0; m < 4; ++m) _Pragma("unroll") for (int k = 0; k < 2; ++k) dst[m][k] = *(const PG8_LAS bf16x8*)(lds + PG8_SA(b, h) + aoff + m * 2048 + k * 1024); } while (0)
#define PG8_LDB(dst, b, h) do { _Pragma("unroll") for (int n = 0; n < 2; ++n) _Pragma("unroll") for (int k = 0; k < 2; ++k) dst[n][k] = *(const PG8_LAS bf16x8*)(lds + PG8_SB(b, h) + boff + n * 2048 + k * 1024); } while (0)
#define PG8_MMA(ai, bj, At, Bt) do { __builtin_amdgcn_s_setprio(1); _Pragma("unroll") for (int m = 0; m < 4; ++m) _Pragma("unroll") for (int n = 0; n < 2; ++n) _Pragma("unroll") for (int k = 0; k < 2; ++k) \
        acc[ai][bj][m][n] = __builtin_amdgcn_mfma_f32_16x16x32_bf16(Bt[n][k], At[m][k], acc[ai][bj][m][n], 0, 0, 0); __builtin_amdgcn_s_setprio(0); } while (0)
#define PG8_WAIT_V(n) asm volatile("s_waitcnt vmcnt(" #n ")" ::: "memory")
#define PG8_WAIT_L(n) asm volatile("s_waitcnt lgkmcnt(" #n ")" ::: "memory")
#define PG8_BAR __builtin_amdgcn_s_barrier()
#define PG8_SCHED __builtin_amdgcn_sched_barrier(0)
    Unit cur, nxt; int ui = 0;
    if (!S.next(0, cur)) return;
    f32x4 acc[2][2][4][2];
#pragma unroll
    for (int a = 0; a < 2; ++a)
#pragma unroll
        for (int b = 0; b < 2; ++b)
#pragma unroll
            for (int m = 0; m < 4; ++m)
#pragma unroll
                for (int n = 0; n < 2; ++n) acc[a][b][m][n] = (f32x4){0.f, 0.f, 0.f, 0.f};
    bf16x8 At[4][2], B0[2][2], B1[2][2];
    const char* cA = (const char*)g.A + (size_t)cur.pm * tstepA; const char* cB = (const char*)g.Bt + (size_t)cur.pn * tstepB;
    S.a_ready(cur);
    if constexpr (SP2) {
        PG8_STAGE(PG8_SB(0, 0), cB, voffB); PG8_STAGE(PG8_SB(0, 1), cB + hstepB, voffB); PG8_STAGE(PG8_SA(0, 0), cA, voffA); PG8_STAGE(PG8_SA(0, 1), cA + hstepA, voffA);
        if (wr == 1) PG8_BAR;
        PG8_WAIT_V(2); PG8_BAR;
        PG8_STAGE(PG8_SB(1, 0), cB + kstep, voffB); PG8_STAGE(PG8_SA(1, 0), cA + kstep, voffA); PG8_STAGE(PG8_SB(1, 1), cB + hstepB + kstep, voffB);
        PG8_WAIT_V(6); PG8_BAR;
    } else {
        PG8_STAGE(PG8_SB(0, 0), cB, voffB); PG8_STAGE(PG8_SA(0, 0), cA, voffA); PG8_STAGE(PG8_SB(0, 1), cB + hstepB, voffB); PG8_STAGE(PG8_SA(0, 1), cA + hstepA, voffA);
        if (wr == 1) PG8_BAR;
        PG8_WAIT_V(4); PG8_BAR;
        PG8_STAGE(PG8_SB(1, 0), cB + kstep, voffB); PG8_STAGE(PG8_SA(1, 0), cA + kstep, voffA); PG8_STAGE(PG8_SB(1, 1), cB + hstepB + kstep, voffB);
        PG8_WAIT_V(6); PG8_BAR;
    }
    for (;;) {
        const bool has_next = S.next(ui + 1, nxt);
        const char* nA = has_next ? (const char*)g.A + (size_t)nxt.pm * tstepA : cA; const char* nB = has_next ? (const char*)g.Bt + (size_t)nxt.pn * tstepB : cB;
        for (int t = 0; t < nt; t += 2) {
            const bool last = (t == nt - 2);
            const char* a1 = cA + (size_t)(t + 1) * kstep;
            const char* a2 = last ? nA : cA + (size_t)(t + 2) * kstep; const char* b2 = last ? nB : cB + (size_t)(t + 2) * kstep;
            const char* a3 = a2 + kstep; const char* b3 = b2 + kstep;
            if (last && has_next) S.a_ready(nxt);
            if constexpr (SP2) {
            PG8_LDB(B0, 0, 0); PG8_LDB(B1, 0, 1); PG8_SCHED; PG8_LDA(At, 0, 0); PG8_STAGE(PG8_SA(1, 1), a1 + hstepA, voffA);
            PG8_WAIT_V(8); PG8_WAIT_L(0); PG8_BAR; PG8_MMA(0, 0, At, B0); PG8_MMA(0, 1, At, B1); PG8_BAR; PG8_SCHED;
            PG8_LDA(At, 0, 1); PG8_STAGE(PG8_SB(0, 0), b2, voffB); PG8_STAGE(PG8_SB(0, 1), b2 + hstepB, voffB); PG8_STAGE(PG8_SA(0, 0), a2, voffA);
            PG8_WAIT_V(8); PG8_WAIT_L(0); PG8_BAR; PG8_MMA(1, 0, At, B0); PG8_MMA(1, 1, At, B1); PG8_BAR; PG8_SCHED;
            PG8_LDB(B0, 1, 0); PG8_LDB(B1, 1, 1); PG8_SCHED; PG8_LDA(At, 1, 0); PG8_STAGE(PG8_SA(0, 1), a2 + hstepA, voffA);
            PG8_WAIT_V(8); PG8_WAIT_L(0); PG8_BAR; PG8_MMA(0, 0, At, B0); PG8_MMA(0, 1, At, B1); PG8_BAR; PG8_SCHED;
            PG8_LDA(At, 1, 1); PG8_STAGE(PG8_SB(1, 0), b3, voffB); PG8_STAGE(PG8_SB(1, 1), b3 + hstepB, voffB); PG8_STAGE(PG8_SA(1, 0), a3, voffA);
            PG8_WAIT_V(8); PG8_WAIT_L(0); PG8_BAR; PG8_MMA(1, 0, At, B0); PG8_MMA(1, 1, At, B1); PG8_BAR; PG8_SCHED;
            } else {
            PG8_LDB(B0, 0, 0); PG8_SCHED; PG8_LDA(At, 0, 0); PG8_STAGE(PG8_SA(1, 1), a1 + hstepA, voffA);
            PG8_WAIT_L(8); PG8_BAR; PG8_WAIT_L(0); PG8_MMA(0, 0, At, B0); PG8_BAR; PG8_SCHED;
            PG8_LDB(B1, 0, 1); PG8_STAGE(PG8_SB(0, 0), b2, voffB);
            PG8_BAR; PG8_WAIT_L(0); PG8_MMA(0, 1, At, B1); PG8_BAR;
            PG8_LDA(At, 0, 1); PG8_STAGE(PG8_SA(0, 0), a2, voffA);
            PG8_BAR; PG8_WAIT_L(0); PG8_MMA(1, 0, At, B0); PG8_BAR; PG8_SCHED;
            PG8_STAGE(PG8_SB(0, 1), b2 + hstepB, voffB);
            PG8_WAIT_V(6); PG8_BAR; PG8_MMA(1, 1, At, B1); PG8_BAR;
            PG8_LDB(B0, 1, 0); PG8_SCHED; PG8_LDA(At, 1, 0); PG8_STAGE(PG8_SA(0, 1), a2 + hstepA, voffA);
            PG8_WAIT_L(8); PG8_BAR; PG8_WAIT_L(0); PG8_MMA(0, 0, At, B0); PG8_BAR; PG8_SCHED;
            PG8_LDB(B1, 1, 1); PG8_STAGE(PG8_SB(1, 0), b3, voffB);
            PG8_BAR; PG8_WAIT_L(0); PG8_MMA(0, 1, At, B1); PG8_BAR;
            PG8_LDA(At, 1, 1); PG8_STAGE(PG8_SA(1, 0), a3, voffA);
            PG8_BAR; PG8_WAIT_L(0); PG8_MMA(1, 0, At, B0); PG8_BAR; PG8_SCHED;
            PG8_STAGE(PG8_SB(1, 1), b3 + hstepB, voffB);
            PG8_WAIT_V(6); PG8_BAR; PG8_MMA(1, 1, At, B1); PG8_BAR;
            }
        }
        if constexpr (ALIGN_EPI) { if (wr == 0) PG8_BAR; }
        if constexpr (!Epi::AFTER_DRAIN) { E(acc, cur, wr, wc, fr, fq); S.done(cur); }
        if (!has_next) break;
#pragma unroll
        for (int a = 0; a < 2; ++a)
#pragma unroll
            for (int b = 0; b < 2; ++b)
#pragma unroll
                for (int m = 0; m < 4; ++m)
#pragma unroll
                    for (int n = 0; n < 2; ++n) acc[a][b][m][n] = (f32x4){0.f, 0.f, 0.f, 0.f};
        cur = nxt; cA = nA; cB = nB; ++ui;
        if constexpr (ALIGN_EPI) { if (wr == 1) PG8_BAR; }
    }
    PG8_WAIT_V(0);
    if constexpr (!ALIGN_EPI) { if (wr == 0) PG8_BAR; }
    PG8_BAR;
    if constexpr (Epi::AFTER_DRAIN) { E.fused(acc, cur, wr, wc, fr, fq, lds, wid, lane); S.done(cur); }
#undef PG8_SA
#undef PG8_SB
#undef PG8_STAGE
#undef PG8_LDA
#undef PG8_LDB
#undef PG8_MMA
#undef PG8_WAIT_V
#undef PG8_WAIT_L
#undef PG8_BAR
#undef PG8_SCHED
}
}
using pg8::bf16_t; using pg8::bf16x8; using pg8::f32x4; using pg8::u32x4;
#define LAS __attribute__((address_space(3)))
typedef float f32x16 __attribute__((ext_vector_type(16)));
typedef float f32x2 __attribute__((ext_vector_type(2)));
typedef unsigned u32x2 __attribute__((ext_vector_type(2)));
typedef short s16x4 __attribute__((ext_vector_type(4)));

constexpr int SEQ = 8192, NB = 2, M = NB * SEQ, D = 1024, DIN = 2560, DFF = 2816, NUP = 2 * DFF, DEPTH = 2;
constexpr int NH = 4, HD = 64, VD = 128;
constexpr float NORM_EPS = 1e-6f, SUBLN_EPS = 1e-5f, LN_EPS = 1e-5f;
constexpr float LOG2E = 1.4426950408889634f;
constexpr float QSCALE = 0.125f * LOG2E;
constexpr int P4_ROWS = 248, P4_TILES = (M + P4_ROWS - 1) / P4_ROWS;

constexpr size_t MiB = 1u << 20;
constexpr size_t WS_SS = 0;
constexpr size_t WS_W = 1 * MiB;
constexpr size_t W_IN = 0, W_OUT = 5 * MiB, W_UP = 7 * MiB, W_DOWN = 18 * MiB, W_LAYER = 47 * MiB / 2;
constexpr size_t WS_XB = 48 * MiB;
constexpr size_t WS_Z = 80 * MiB;
constexpr size_t WS_MIX = 160 * MiB;
constexpr size_t WS_Y = 80 * MiB;
constexpr size_t WS_OP1 = 192 * MiB;
constexpr size_t WS_CTL = 224 * MiB, CTL_BYTES = 131072;
constexpr size_t WS_END = 225 * MiB;
static_assert(WS_W + 2 * W_LAYER <= WS_XB && WS_Y + (size_t)M * DFF * 2 <= WS_OP1 && WS_MIX + (size_t)M * D * 2 <= WS_OP1, "ws map");

constexpr int RING_BYTES = 131072, LDS_BYTES = 147456;

__device__ __forceinline__ unsigned f2bf(float f) { unsigned u = __builtin_bit_cast(unsigned, f); return (u + 0x7fffu + ((u >> 16) & 1u)) >> 16; }
__device__ __forceinline__ unsigned pk2(float lo, float hi) { return f2bf(lo) | (f2bf(hi) << 16); }
__device__ __forceinline__ unsigned cvtpk(float lo, float hi) { return pg8::cvt_pk_bf16(lo, hi); }
__device__ __forceinline__ float bf2f(unsigned short b) { return __builtin_bit_cast(float, (unsigned)b << 16); }
__device__ __forceinline__ float bflo(unsigned w) { return __builtin_bit_cast(float, w << 16); }
__device__ __forceinline__ float bfhi(unsigned w) { return __builtin_bit_cast(float, w & 0xffff0000u); }
__device__ __forceinline__ float shx(float v, int mask, int lane) { return __builtin_bit_cast(float, __builtin_amdgcn_ds_bpermute((lane ^ mask) << 2, __builtin_bit_cast(int, v))); }
__device__ __forceinline__ float wave_sum(float v, int lane) {
#pragma unroll
    for (int o = 1; o < 64; o <<= 1) v += shx(v, o, lane);
    return v;
}
__device__ __forceinline__ float gelu_t(float x) {
    const float u = x * (1.0f + 0.044715f * x * x);
    const float e = __builtin_amdgcn_exp2f(-2.302208198f * u);
    return x * __builtin_amdgcn_rcpf(1.0f + e);
}
__device__ __forceinline__ f32x2 gelu_t2(f32x2 x) {
    f32x2 t = x * x; t = t * 0.044715f + 1.0f; const f32x2 u = (x * t) * (-2.302208198f);
    f32x2 e; e.x = __builtin_amdgcn_exp2f(u.x); e.y = __builtin_amdgcn_exp2f(u.y); e = e + 1.0f;
    f32x2 r; r.x = __builtin_amdgcn_rcpf(e.x); r.y = __builtin_amdgcn_rcpf(e.y);
    return x * r;
}
__device__ __forceinline__ float row_rstd(const float* ss, int row, float eps) {
    const f32x4* p = (const f32x4*)(ss + (size_t)row * 16);
    const f32x4 a = p[0], b = p[1], c = p[2], d = p[3];
    const float s = (((a[0] + a[1]) + (a[2] + a[3])) + ((b[0] + b[1]) + (b[2] + b[3]))) + (((c[0] + c[1]) + (c[2] + c[3])) + ((d[0] + d[1]) + (d[2] + d[3])));
    return __builtin_amdgcn_rsqf(s * (1.0f / D) + eps);
}
constexpr int RSTAB_OFF = RING_BYTES;
template <bool P4MAP, class Sched> __device__ __forceinline__ void fill_rstd(LAS unsigned char* lds, const Sched& S, const float* ss) {
    int t = threadIdx.x; asm volatile("" : "+v"(t));
    LAS float* tab = (LAS float*)(lds + RSTAB_OFF); pg8::Unit u;
    const int r = t & 255, h = t >> 8;
#pragma unroll
    for (int k = 0; k < 4; ++k) { const int i = 2 * k + h;
        if (S.next(i, u)) {
            int tok = P4MAP ? u.pm * P4_ROWS + 62 * (r >> 6) + (r & 63) - 2 : u.pm * 256 + r; tok = tok < 0 ? 0 : (tok > M - 1 ? M - 1 : tok);
            tab[i * 256 + r] = row_rstd(ss, tok, NORM_EPS); } }
    __syncthreads();
}

struct EpiInProj {
    static constexpr bool PERM = true, AFTER_DRAIN = false;
    bf16_t* Z; LAS const float* tab; bool wt;
    __device__ __forceinline__ void operator()(f32x4 (&acc)[2][2][4][2], const pg8::Unit& u, int wr, int wc, int fr, int fq) const {
        asm volatile("" : "+v"(fr), "+v"(fq));
        const __amdgpu_buffer_rsrc_t zr = __builtin_amdgcn_make_buffer_rsrc((void*)Z, 0, M * DIN * 2, 0x00020000);
        const int row0 = u.pm * 256 + wr * 64 + fr, col0 = u.pn * 256 + wc * 32 + 8 * fq;
#pragma unroll
        for (int ai = 0; ai < 2; ++ai)
#pragma unroll
            for (int m = 0; m < 4; ++m) {
                const int row = row0 + ai * 128 + m * 16; const float rs = tab[u.ui * 256 + ai * 128 + wr * 64 + m * 16 + fr];
                bf16_t* rowp = Z + (size_t)row * DIN + col0;
#pragma unroll
                for (int bj = 0; bj < 2; ++bj) { const f32x4 v0 = acc[ai][bj][m][0] * rs, v1 = acc[ai][bj][m][1] * rs;
                    u32x4 w; w.x = cvtpk(v0[0], v0[1]); w.y = cvtpk(v0[2], v0[3]); w.z = cvtpk(v1[0], v1[1]); w.w = cvtpk(v1[2], v1[3]);
                    if (wt && u.ui == 0) __builtin_amdgcn_raw_buffer_store_b128(w, zr, (unsigned)(((size_t)row * DIN + col0 + bj * 128) * 2), 0,   16);
                    else *(u32x4*)(rowp + bj * 128) = w; }
            }
    }
};
struct InProjOrder {
    pg8::StaticOrder A, B; unsigned* cnt; bool pub;
    __device__ void init(int G_, int c_, unsigned* cnt_, bool pub_) { A.init(M, 1024, G_, c_); B.init(M, 1536, G_, c_); cnt = cnt_; pub = pub_; }
    __device__ bool next(int i, pg8::Unit& u) const { if (i == 0) { const bool ok = A.next(0, u); u.pn += 6; u.ui = 0; return ok; } const bool ok = B.next(i - 1, u); u.ui = i; return ok; }
    __device__ __forceinline__ void a_ready(const pg8::Unit&) const {}
    __device__ __forceinline__ void done(const pg8::Unit& u) const {
        if (pub && u.ui == 0) { asm volatile("s_waitcnt vmcnt(0)" ::: "memory"); __builtin_amdgcn_s_barrier(); asm volatile("" ::: "memory");
            if (threadIdx.x == 0) __hip_atomic_fetch_add(cnt, 1u, __ATOMIC_RELAXED, __HIP_MEMORY_SCOPE_AGENT); }
    }
};
struct EpiRes {
    static constexpr bool PERM = true, AFTER_DRAIN = false;
    const float* resf; bf16_t* xb; float* ss;
    __device__ __forceinline__ void operator()(f32x4 (&acc)[2][2][4][2], const pg8::Unit& u, int wr, int wc, int fr, int fq) const {
        asm volatile("" : "+v"(fr), "+v"(fq));
        const int col0 = u.pn * 256 + wc * 32 + 8 * fq;
#pragma unroll
        for (int ai = 0; ai < 2; ++ai)
#pragma unroll
            for (int m = 0; m < 4; ++m) {
                const int row = u.pm * 256 + ai * 128 + wr * 64 + m * 16 + fr; float sq = 0.f;
#pragma unroll
                for (int bj = 0; bj < 2; ++bj) { const size_t off = (size_t)row * D + col0 + bj * 128;
                    f32x4 r0, r1;
                    if (resf) { r0 = *(const f32x4*)(resf + off); r1 = *(const f32x4*)(resf + off + 4); }
                    else { const u32x4 w = *(const u32x4*)(xb + off); r0 = (f32x4){bflo(w.x), bfhi(w.x), bflo(w.y), bfhi(w.y)}; r1 = (f32x4){bflo(w.z), bfhi(w.z), bflo(w.w), bfhi(w.w)}; }
                    const f32x4 o0 = r0 + acc[ai][bj][m][0], o1 = r1 + acc[ai][bj][m][1];
                    sq += ((o0[0] * o0[0] + o0[1] * o0[1]) + (o0[2] * o0[2] + o0[3] * o0[3])) + ((o1[0] * o1[0] + o1[1] * o1[1]) + (o1[2] * o1[2] + o1[3] * o1[3]));
                    u32x4 w; w.x = cvtpk(o0[0], o0[1]); w.y = cvtpk(o0[2], o0[3]); w.z = cvtpk(o1[0], o1[1]); w.w = cvtpk(o1[2], o1[3]);
                    *(u32x4*)(xb + off) = w; }
                { const int ln_ = fq * 16 + fr; sq += shx(sq, 16, ln_); sq += shx(sq, 32, ln_); }
                if (fq == 0) ss[(size_t)row * 16 + u.pn * 4 + wc] = sq;
            }
    }
};
struct EpiResFinal {
    static constexpr bool PERM = true, AFTER_DRAIN = false;
    const bf16_t* xb; float* ss; float* out; const float* fg; unsigned* cnt; LAS float* tab;
    __device__ __forceinline__ void operator()(f32x4 (&acc)[2][2][4][2], const pg8::Unit& u, int wr, int wc, int fr, int fq) const {
        asm volatile("" : "+v"(fr), "+v"(fq));
        const int col0 = u.pn * 256 + wc * 32 + 8 * fq;
#pragma unroll
        for (int ai = 0; ai < 2; ++ai)
#pragma unroll
            for (int m = 0; m < 4; ++m) {
                const int row = u.pm * 256 + ai * 128 + wr * 64 + m * 16 + fr; float sq = 0.f;
#pragma unroll
                for (int bj = 0; bj < 2; ++bj) { const size_t off = (size_t)row * D + col0 + bj * 128;
                    const u32x4 w = *(const u32x4*)(xb + off);
                    const f32x4 o0 = (f32x4){bflo(w.x), bfhi(w.x), bflo(w.y), bfhi(w.y)} + acc[ai][bj][m][0], o1 = (f32x4){bflo(w.z), bfhi(w.z), bflo(w.w), bfhi(w.w)} + acc[ai][bj][m][1];
                    sq += ((o0[0] * o0[0] + o0[1] * o0[1]) + (o0[2] * o0[2] + o0[3] * o0[3])) + ((o1[0] * o1[0] + o1[1] * o1[1]) + (o1[2] * o1[2] + o1[3] * o1[3]));
                    acc[ai][bj][m][0] = o0; acc[ai][bj][m][1] = o1; }
                { const int ln_ = fq * 16 + fr; sq += shx(sq, 16, ln_); sq += shx(sq, 32, ln_); }
                if (fq == 0) __hip_atomic_store(ss + (size_t)row * 16 + u.pn * 4 + wc, sq, __ATOMIC_RELAXED, __HIP_MEMORY_SCOPE_AGENT);
            }
        asm volatile("s_waitcnt vmcnt(0)" ::: "memory"); __builtin_amdgcn_s_barrier(); asm volatile("" ::: "memory");
        int t = threadIdx.x; asm volatile("" : "+v"(t));
        if (t == 0) { unsigned* c = cnt + 64 * u.pm; __hip_atomic_fetch_add(c, 1u, __ATOMIC_RELAXED, __HIP_MEMORY_SCOPE_AGENT);
            unsigned sp = 0; while (__hip_atomic_load(c, __ATOMIC_RELAXED, __HIP_MEMORY_SCOPE_AGENT) < 4u) { __builtin_amdgcn_s_sleep(1); if (++sp > (1u << 22)) break; }
            __builtin_amdgcn_fence(__ATOMIC_ACQUIRE, "agent"); asm volatile("s_waitcnt vmcnt(0)" ::: "memory"); }
        __builtin_amdgcn_s_barrier(); asm volatile("" ::: "memory");
        if (t < 256) tab[t] = row_rstd(ss, u.pm * 256 + t, NORM_EPS);
        asm volatile("s_waitcnt lgkmcnt(0)" ::: "memory"); __builtin_amdgcn_s_barrier(); asm volatile("" ::: "memory");
        f32x4 g0[2], g1[2];
#pragma unroll
        for (int bj = 0; bj < 2; ++bj) { g0[bj] = *(const f32x4*)(fg + col0 + bj * 128); g1[bj] = *(const f32x4*)(fg + col0 + bj * 128 + 4); }
#pragma unroll
        for (int ai = 0; ai < 2; ++ai)
#pragma unroll
            for (int m = 0; m < 4; ++m) {
                const int lr = ai * 128 + wr * 64 + m * 16 + fr; const float rs = tab[lr]; float* op = out + (size_t)(u.pm * 256 + lr) * D + col0;
#pragma unroll
                for (int bj = 0; bj < 2; ++bj) { __builtin_nontemporal_store(acc[ai][bj][m][0] * rs * g0[bj], (f32x4*)(op + bj * 128)); __builtin_nontemporal_store(acc[ai][bj][m][1] * rs * g1[bj], (f32x4*)(op + bj * 128 + 4)); }
            }
    }
};
template <int CTRL> __device__ __forceinline__ float dppf(float old, float src) {
    return __builtin_bit_cast(float, __builtin_amdgcn_update_dpp(__builtin_bit_cast(int, old), __builtin_bit_cast(int, src), CTRL, 0xf, 0xf, false)); }
template <int CTRL> __device__ __forceinline__ float dppz(float src) {
    return __builtin_bit_cast(float, __builtin_amdgcn_mov_dpp(__builtin_bit_cast(int, src), CTRL, 0xf, 0xf, true)); }
struct EpiConvGate {
    static constexpr bool PERM = true, AFTER_DRAIN = false;
    bf16_t* Y; LAS const float* tab; const float* cw; const float* cb;
    template <bool MASK> __device__ __forceinline__ void run(f32x4 (&acc)[2][2][4][2], const pg8::Unit& u, int wr, int wc, int fr, int fq) const {
        const int ch0 = u.pn * 128 + wc * 32 + 8 * fq;
        u32x2 park[2][4];
#pragma unroll
        for (int n = 0; n < 2; ++n) {
            asm volatile("" ::: "memory");
            const int ch = ch0 + 4 * n;
            f32x4 w0[2], w1[2], w2[2], bb[2];
#pragma unroll
            for (int bj = 0; bj < 2; ++bj) { const int col = bj * DFF + ch;
                w0[bj] = *(const f32x4*)(cw + col); w1[bj] = *(const f32x4*)(cw + NUP + col); w2[bj] = *(const f32x4*)(cw + 2 * NUP + col); bb[bj] = *(const f32x4*)(cb + col); }
#pragma unroll
            for (int ai = 0; ai < 2; ++ai)
#pragma unroll
                for (int m = 0; m < 4; ++m) {
                    const int tok = u.pm * P4_ROWS + 62 * (2 * ai + wr) + 16 * m + fr - 2; const int tpos = tok & (SEQ - 1);
                    f32x4 o[2];
#pragma unroll
                    for (int bj = 0; bj < 2; ++bj) {
                        const f32x4 cur = acc[ai][bj][m][n]; const f32x4 prv = acc[ai][bj][m > 0 ? m - 1 : 0][n];
                        f32x4 p1, p2;
#pragma unroll
                        for (int i = 0; i < 4; ++i) {
                            p1[i] = dppf<0x111>(dppz<0x10f>(prv[i]), cur[i]);
                            p2[i] = dppf<0x112>(dppz<0x10e>(prv[i]), cur[i]);
                            if (MASK) { p1[i] = tpos >= 1 ? p1[i] : 0.f; p2[i] = tpos >= 2 ? p2[i] : 0.f; }
                        }
                        o[bj] = bb[bj] + w2[bj] * cur + w1[bj] * p1 + w0[bj] * p2;
                    }
                    const f32x2 ga = gelu_t2((f32x2){o[0][0], o[0][1]}) * (f32x2){o[1][0], o[1][1]}, gb = gelu_t2((f32x2){o[0][2], o[0][3]}) * (f32x2){o[1][2], o[1][3]};
                    u32x2 w; w.x = cvtpk(ga.x, ga.y); w.y = cvtpk(gb.x, gb.y);
                    if (n == 0) park[ai][m] = w;
                    else if ((m > 0 || fr >= 2) && tok < M) { u32x4 w4; w4.x = park[ai][m].x; w4.y = park[ai][m].y; w4.z = w.x; w4.w = w.y; *(u32x4*)(Y + (size_t)tok * DFF + ch0) = w4; }
                }
        }
    }
    __device__ __forceinline__ void operator()(f32x4 (&acc)[2][2][4][2], const pg8::Unit& u, int wr, int wc, int fr, int fq) const {
        asm volatile("" : "+v"(fr), "+v"(fq));
#pragma unroll
        for (int ai = 0; ai < 2; ++ai)
#pragma unroll
            for (int m = 0; m < 4; ++m) {
                const float rs = tab[u.ui * 256 + ai * 128 + wr * 64 + m * 16 + fr];
#pragma unroll
                for (int bj = 0; bj < 2; ++bj)
#pragma unroll
                    for (int n = 0; n < 2; ++n) acc[ai][bj][m][n] *= rs;
            }
        const int t0 = u.pm * P4_ROWS - 2;
        if (((t0 + 255) >> 13) != ((t0 - 2) >> 13)) run<true>(acc, u, wr, wc, fr, fq); else run<false>(acc, u, wr, wc, fr, fq);
    }
};
namespace attn_body {
using bf16=__hip_bfloat16;
using bf16x8=__attribute__((ext_vector_type(8)))short;
using s16x4=__attribute__((ext_vector_type(4)))short;
using f32x16=__attribute__((ext_vector_type(16)))float;
using u32x4=__attribute__((ext_vector_type(4)))unsigned;
constexpr int SEQ=8192,D=64,ZP=2560,OP=512;
constexpr int NW=8,QBLK=32,QB=QBLK*NW,KVBLK=64,NQB=SEQ/QB;
constexpr int ATTN_UNIT_ROWS=QB;
__device__ __forceinline__ int crow(int r,int hi){return (r&3)+8*(r>>2)+4*hi;}
#define SBAR() __builtin_amdgcn_sched_barrier(0)
__device__ __forceinline__ void cmask(f32x16&p0,f32x16&p1,int jb,int qrel,int hi){
  const float NEG=-INFINITY; int kb=64*jb+4*hi;
  #pragma unroll
  for(int r=0;r<16;++r){int kv=kb+(r&3)+8*(r>>2); if(kv>qrel)p0[r]=NEG; if(kv+32>qrel)p1[r]=NEG;}
}

constexpr int NSLOT=3, SLOTB=8192;
constexpr int LDS_K=0, LDS_V=NSLOT*SLOTB, LDS_WS=LDS_V+NSLOT*2*SLOTB, LDS_OST=LDS_WS+NW*64*4, LDS_BYTES=LDS_OST+NW*8192;
constexpr float C2=0.125f*1.4426950408889634f;
__device__ __forceinline__ void glds16(const void*gsrc,unsigned lds_dst){unsigned keep;
  asm volatile("s_mov_b32 %0, m0\n\ts_mov_b32 m0, %2\n\ts_nop 0\n\tglobal_load_lds_dwordx4 %1, off\n\ts_mov_b32 m0, %0":"=&s"(keep):"v"(gsrc),"s"(lds_dst):"memory");}
__device__ __forceinline__ float max3f(float a,float b,float c){float r;asm("v_max3_f32 %0, %1, %2, %3":"=v"(r):"v"(a),"v"(b),"v"(c));return r;}
__device__ __forceinline__ float max2f(float a,float b){float r;asm("v_max_f32_e32 %0, %1, %2":"=v"(r):"v"(a),"v"(b));return r;}
__device__ __forceinline__ float fadd_s(float a,float b){float r;asm("v_add_f32_e32 %0, %1, %2":"=v"(r):"v"(a),"v"(b));return r;}
__device__ __forceinline__ float fsub_s(float a,float b){float r;asm("v_sub_f32_e32 %0, %1, %2":"=v"(r):"v"(a),"v"(b));return r;}
typedef float f32x2_t __attribute__((ext_vector_type(2))); typedef float f32x4_t __attribute__((ext_vector_type(4))); typedef __bf16 bf16x2_t __attribute__((ext_vector_type(2)));
__device__ __forceinline__ unsigned cvtpk_s(float lo,float hi){f32x2_t v={lo,hi};bf16x2_t b=__builtin_convertvector(v,bf16x2_t);return __builtin_bit_cast(unsigned,b);}
__device__ __forceinline__ float bfr(float x){unsigned u=__float_as_uint(x);u=(u+0x7fffu+((u>>16)&1u))&0xffff0000u;return __uint_as_float(u);}
#define WAIT_BAR(N) asm volatile("s_waitcnt vmcnt(" #N ") lgkmcnt(0)\n\ts_barrier":::"memory")

__device__ __forceinline__ void qkt(f32x16&p0,f32x16&p1,const char*Kslot,const bf16x8*qr,const f32x16&c0,const f32x16&c1,int r32,int hi){
  const char*kb=Kslot+hi*1024+r32*16;
  #pragma unroll
  for(int d0=0;d0<4;++d0){
    const bf16x8 b0=*reinterpret_cast<const bf16x8*>(kb+d0*2048);
    const bf16x8 b1=*reinterpret_cast<const bf16x8*>(kb+d0*2048+512);
    if(d0==0){p0=__builtin_amdgcn_mfma_f32_32x32x16_bf16(b0,qr[0],c0,0,0,0);p1=__builtin_amdgcn_mfma_f32_32x32x16_bf16(b1,qr[0],c1,0,0,0);}
    else{p0=__builtin_amdgcn_mfma_f32_32x32x16_bf16(b0,qr[d0],p0,0,0,0);p1=__builtin_amdgcn_mfma_f32_32x32x16_bf16(b1,qr[d0],p1,0,0,0);}}
}
typedef __attribute__((address_space(3))) const char* lds_cptr;
typedef short v4i16_t __attribute__((ext_vector_type(4)));
__device__ __forceinline__ void kload8(bf16x8*kf,lds_cptr kp){
  kf[0]=*(const __attribute__((address_space(3))) bf16x8*)(kp);      kf[1]=*(const __attribute__((address_space(3))) bf16x8*)(kp+512);
  kf[2]=*(const __attribute__((address_space(3))) bf16x8*)(kp+2048); kf[3]=*(const __attribute__((address_space(3))) bf16x8*)(kp+2560);
  kf[4]=*(const __attribute__((address_space(3))) bf16x8*)(kp+4096); kf[5]=*(const __attribute__((address_space(3))) bf16x8*)(kp+4608);
  kf[6]=*(const __attribute__((address_space(3))) bf16x8*)(kp+6144); kf[7]=*(const __attribute__((address_space(3))) bf16x8*)(kp+6656);
}
__device__ __forceinline__ void kload2(bf16x8*kf,lds_cptr kp,int j){ kf[2*j]=*(const __attribute__((address_space(3))) bf16x8*)(kp+j*2048); kf[2*j+1]=*(const __attribute__((address_space(3))) bf16x8*)(kp+j*2048+512); }
__device__ __forceinline__ s16x4 vtr(lds_cptr p){ return __builtin_bit_cast(s16x4,__builtin_amdgcn_ds_read_tr16_b64_v4i16((__attribute__((address_space(3))) v4i16_t*)p)); }
__device__ __forceinline__ float rowmax(const f32x16&p0,const f32x16&p1){
  float a=max3f(p0[0],p0[1],p1[0]),b=max3f(p0[2],p0[3],p1[1]);a=max3f(a,p1[2],p1[3]);
  #pragma unroll
  for(int r=4;r<16;r+=4){a=max3f(a,p0[r],p0[r+1]);b=max3f(b,p0[r+2],p0[r+3]);a=max3f(a,p1[r],p1[r+1]);b=max3f(b,p1[r+2],p1[r+3]);}
  const float m=max2f(a,b);
  auto rr=__builtin_amdgcn_permlane32_swap(__float_as_uint(m),__float_as_uint(m),false,false);
  return max2f(__uint_as_float(rr[0]),__uint_as_float(rr[1]));
}
__device__ __forceinline__ void pv(f32x16*o,int vb,bf16x8 pa0,bf16x8 pa1,bf16x8 pa2,bf16x8 pa3){
  #pragma unroll
  for(int d0=0;d0<4;++d0){s16x4 lo[4],hi[4];
    #pragma unroll
    for(int ks=0;ks<4;++ks){
      asm volatile("ds_read_b64_tr_b16 %0,%1 offset:%c2":"=&v"(lo[ks]):"v"(vb),"i"(d0*4096+ks*1024):"memory");
      asm volatile("ds_read_b64_tr_b16 %0,%1 offset:%c2":"=&v"(hi[ks]):"v"(vb),"i"(d0*4096+ks*1024+512):"memory");}
    asm volatile("s_waitcnt lgkmcnt(0)":::"memory");SBAR();
    #define PK(k) (bf16x8){lo[k][0],lo[k][1],lo[k][2],lo[k][3],hi[k][0],hi[k][1],hi[k][2],hi[k][3]}
    o[d0]=__builtin_amdgcn_mfma_f32_32x32x16_bf16(pa0,PK(0),o[d0],0,0,0);
    o[d0]=__builtin_amdgcn_mfma_f32_32x32x16_bf16(pa1,PK(1),o[d0],0,0,0);
    o[d0]=__builtin_amdgcn_mfma_f32_32x32x16_bf16(pa2,PK(2),o[d0],0,0,0);
    o[d0]=__builtin_amdgcn_mfma_f32_32x32x16_bf16(pa3,PK(3),o[d0],0,0,0);
    #undef PK
  }
}

#ifndef ATTN_STORE16
#define ATTN_STORE16(p,v) (*(u32x4*)(p)=(v))
#endif
template<int THRL> __device__ __forceinline__ void attn_unit(int b,int qb,const bf16*Q,const bf16*__restrict__ K,const bf16*__restrict__ V,bf16*O,char*shm,float slope2,const int F_fmode,unsigned*F_flag,unsigned short*F_mixo,const float F_lam,const float F_gscale,const float*F_sg){
  int tid_=threadIdx.x; asm volatile("":"+v"(tid_));
  const int tid=tid_,lane=tid&63,r32=lane&31,hi=lane>>5; const int wid=__builtin_amdgcn_readfirstlane(tid>>6);
  const long rowbase=(long)b*SEQ; const int q0=qb*QB;
  const bf16*Qw=Q+(rowbase+q0+wid*QBLK)*ZP;
  const bf16*Kh=K+rowbase*ZP,*Vh=V+rowbase*ZP;
  const unsigned lds0=(unsigned)(uintptr_t)shm;
  float*wsf=(float*)(shm+LDS_WS)+wid*64;
  const bf16*ksrc=Kh+(long)lane*ZP+wid*8;
  const bf16*vsrc=Vh+(long)(16*(wid&3)+(lane>>2))*ZP+(wid>>2)*32+(lane&3)*8;
  const unsigned kdst=lds0+LDS_K+wid*1024, vdst=lds0+LDS_V+wid*1024;
  #define DMA_K(t,slot) glds16(ksrc+(long)(t)*KVBLK*ZP,(unsigned)__builtin_amdgcn_readfirstlane(kdst+(slot)))
  #define DMA_V(t,slot) do{ glds16(vsrc+(long)(t)*KVBLK*ZP,(unsigned)__builtin_amdgcn_readfirstlane(vdst+2*(slot))); glds16(vsrc+64+(long)(t)*KVBLK*ZP,(unsigned)__builtin_amdgcn_readfirstlane(vdst+8192+2*(slot))); }while(0)
  const int vb0=(int)(lds0+LDS_V)+((lane>>4)&1)*32+(lane&3)*8+(4*hi+((lane&15)>>2))*64;
  const char*Kbase=shm+LDS_K; bf16x8 kf[8];
  const lds_cptr shm3=(lds_cptr)shm; const lds_cptr kp0=shm3+LDS_K+hi*1024+r32*16; const lds_cptr vp0=shm3+LDS_V+((lane>>4)&1)*32+(lane&3)*8+(4*hi+((lane&15)>>2))*64;
  const int NT=(q0+QB)/KVBLK;
  bf16x8 qbf; unsigned locA,locB; constexpr unsigned kbA0=0u,kbB0=0u;
  { float sl_=slope2; asm volatile("":"+v"(sl_));
    const float a1=bfr(sl_), r1=sl_-a1, a2=bfr(r1), a3=bfr(r1-a2);
    const unsigned A1=__float_as_uint(a1)>>16,A2=__float_as_uint(a2)>>16,A3=__float_as_uint(a3)>>16,B1=__float_as_uint(64.f*a1)>>16,B2=__float_as_uint(64.f*a2)>>16,B3=__float_as_uint(64.f*a3)>>16;
    const u32x4 w=hi?(u32x4){0u,0u,0u,0u}:(u32x4){A1|(A2<<16),A3|(B1<<16),B2|(B3<<16),0u}; qbf=__builtin_bit_cast(bf16x8,w);
    locA=hi?0u:(__float_as_uint((float)r32)>>16); locB=hi?0u:(__float_as_uint((float)(r32+32))>>16); }
  const unsigned one2=hi?0u:0x3f803f80u;
  #define SETM() do{ const float mh_=bfr(mhat), ml_=mhat-mh_; u32x4 w_=__builtin_bit_cast(u32x4,qbf); w_.w=hi?0u:((__float_as_uint(-mh_)>>16)|(__float_as_uint(-ml_)&0xffff0000u)); qbf=__builtin_bit_cast(bf16x8,w_); }while(0)
  #define TRB(t) (hi?0u:(__float_as_uint((float)((t)-(NT-4)))>>16))
  #define KBIAS(t,W0,LOC,TB) ({ unsigned l_=(LOC); asm volatile("":"+v"(l_)); __builtin_bit_cast(bf16x8,(u32x4){l_|(l_<<16),l_|((TB)<<16),(TB)|((TB)<<16),one2}); })
  #define BIASC(t,W0,LOC,TB) __builtin_amdgcn_mfma_f32_32x32x16_bf16(KBIAS(t,W0,LOC,TB),qbf,f32x16{},0,0,0)
  DMA_K(0,0);DMA_V(0,0);DMA_K(1,SLOTB);
  bf16x8 qr[4];
  #pragma unroll
  for(int d0=0;d0<4;++d0)qr[d0]=*reinterpret_cast<const bf16x8*>(&Qw[(long)r32*ZP+d0*16+hi*8]);
  const int qrel=wid*QBLK+r32;
  float mhat=__builtin_ceilf(slope2*(float)(qrel+1))+16.f,l_reg=0.f;f32x16 o[4];o[0]=f32x16{};o[1]=f32x16{};o[2]=f32x16{};o[3]=f32x16{}; SETM();
  #define CMASK(P0,P1,t) do{int jb_=(t)-(NT-4); if(jb_>=0)cmask(P0,P1,jb_,qrel,hi);}while(0)
  bool resc=false;
  #define START(P0,P1) do{ const float rm=rowmax(P0,P1); resc=false; \
    { const float dl=__builtin_ceilf(__builtin_fmaxf(rm,0.f)); mhat=fadd_s(mhat,dl); \
      _Pragma("unroll") for(int r=0;r<16;++r){P0[r]=fsub_s(P0[r],dl);P1[r]=fsub_s(P1[r],dl);} \
      SETM(); } \
    _Pragma("unroll") for(int r=0;r<16;++r)P0[r]=__builtin_amdgcn_exp2f(P0[r]); }while(0)
  #define RESC() do{ if(resc){ asm volatile("s_waitcnt lgkmcnt(0)":::"memory"); \
      _Pragma("unroll") for(int d_=0;d_<4;++d_) _Pragma("unroll") for(int r=0;r<16;++r)o[d_][r]*=wsf[crow(r,hi)]; } }while(0)
  f32x16 pA0,pA1,pB0,pB1;
  int sl_prev=0,sl_cur=0,sl_next=SLOTB;
  #define ROT() do{sl_prev=sl_cur;sl_cur=sl_next;sl_next=(sl_next==(NSLOT-1)*SLOTB)?0:sl_next+SLOTB;}while(0)
  DMA_K(2,2*SLOTB);
  WAIT_BAR(4);
  { const unsigned tb0_=TRB(0); const f32x16 c0_=BIASC(0,kbA0,locA,tb0_), c1_=BIASC(0,kbB0,locB,tb0_); qkt(pA0,pA1,Kbase,qr,c0_,c1_,r32,hi); } asm volatile("s_nop 15\n\ts_nop 7":"+v"(pA0),"+v"(pA1));CMASK(pA0,pA1,0);
  START(pA0,pA1);
  _Pragma("unroll") for(int r=0;r<16;++r)pA1[r]=__builtin_amdgcn_exp2f(pA1[r]);
  WAIT_BAR(0);
  DMA_K(3,0);DMA_V(1,SLOTB);
  ROT();
  kload8(kf,kp0+sl_cur);
  WAIT_BAR(3);
  s16x4 vlo[8],vhi[8]; u32x4 pw0,pw1,pw2,pw3;
  #define PKW(P,B) cvtpk_s(P[B],P[B+1])
  #define PAF(k) __builtin_bit_cast(bf16x8,pw##k)
  #define VFR(i) (bf16x8){vlo[i][0],vlo[i][1],vlo[i][2],vlo[i][3],vhi[i][0],vhi[i][1],vhi[i][2],vhi[i][3]}
  #define PIN(x) asm volatile("":"+v"(x))
  #define MX3(a,b,c) __builtin_fmaxf(__builtin_fmaxf((a),(b)),(c))
  #define GAPA(MF,A0,A1,A2,A3,W0,W1,PW) do{ MF; sacc+=A0; sacc+=A1; sacc+=A2; sacc+=A3; PIN(sacc); W0; W1; PIN(PW); SBAR(); }while(0)
  #define EX(v) __builtin_amdgcn_exp2f(v)
  #define GAPB(MF,X,B) do{ MF; X[B]=EX(X[B]); X[B+1]=EX(X[B+1]); X[B+2]=EX(X[B+2]); X[B+3]=EX(X[B+3]); PIN(X); SBAR(); }while(0)
  #define VRD(s_,db_,ks_) do{ vlo[s_]=vtr(vp_+((db_)*4096+(ks_)*1024)); vhi[s_]=vtr(vp_+((db_)*4096+(ks_)*1024+512)); }while(0)
  #define GAPB2(MF,X,B) do{ MF; X[B]=EX(X[B]); X[B+1]=EX(X[B+1]); PIN(X); SBAR(); }while(0)
  #define KRD(G,j) do{ if(G){ kload2(kf,kp0+sl_next,j); SBAR(); } }while(0)
  #define STEP(C0,C1,P0,P1,t,GK,GV,GL) do{ SBAR(); \
    const lds_cptr vp_=vp0+2*sl_prev; \
    const unsigned tb_=TRB(t); \
    VRD(0,0,0); SBAR(); float sacc=(P0[0]+P0[1]); \
    GAPA(C0=__builtin_amdgcn_mfma_f32_32x32x16_bf16(kf[0],qr[0],BIASC(t,kbA0,locA,tb_),0,0,0), P0[2],P0[3],P0[4],P0[5],     pw0[0]=PKW(P0,0), pw0[1]=PKW(P0,2), pw0); \
    VRD(1,1,0); SBAR(); GAPA(C1=__builtin_amdgcn_mfma_f32_32x32x16_bf16(kf[1],qr[0],BIASC(t,kbB0,locB,tb_),0,0,0), P0[6],P0[7],P0[8],P0[9],     pw0[2]=PKW(P0,4), pw0[3]=PKW(P0,6), pw0); \
    VRD(2,2,0); SBAR(); GAPA(C0=__builtin_amdgcn_mfma_f32_32x32x16_bf16(kf[2],qr[1],C0,0,0,0),   P0[10],P0[11],P0[12],P0[13], pw1[0]=PKW(P0,8), pw1[1]=PKW(P0,10), pw1); \
    VRD(3,3,0); SBAR(); GAPA(C1=__builtin_amdgcn_mfma_f32_32x32x16_bf16(kf[3],qr[1],C1,0,0,0),   P0[14],P0[15],P1[0],P1[1],   pw1[2]=PKW(P0,12),pw1[3]=PKW(P0,14), pw1); \
    VRD(4,0,1); SBAR(); GAPA(C0=__builtin_amdgcn_mfma_f32_32x32x16_bf16(kf[4],qr[2],C0,0,0,0),   P1[2],P1[3],P1[4],P1[5],     pw2[0]=PKW(P1,0), pw2[1]=PKW(P1,2), pw2); \
    VRD(5,1,1); SBAR(); GAPA(C1=__builtin_amdgcn_mfma_f32_32x32x16_bf16(kf[5],qr[2],C1,0,0,0),   P1[6],P1[7],P1[8],P1[9],     pw2[2]=PKW(P1,4), pw2[3]=PKW(P1,6), pw2); \
    VRD(6,2,1); SBAR(); GAPA(C0=__builtin_amdgcn_mfma_f32_32x32x16_bf16(kf[6],qr[3],C0,0,0,0),   P1[10],P1[11],P1[12],P1[13], pw3[0]=PKW(P1,8), pw3[1]=PKW(P1,10), pw3); \
    VRD(7,3,1); SBAR(); GAPA(C1=__builtin_amdgcn_mfma_f32_32x32x16_bf16(kf[7],qr[3],C1,0,0,0),   P1[14],P1[15],0.f,0.f,       pw3[2]=PKW(P1,12),pw3[3]=PKW(P1,14), pw3); \
    l_reg+=sacc; \
    if(GK){DMA_K((t)+3,sl_cur);} if(GV){DMA_V((t)+1,sl_next);} \
    CMASK(C0,C1,t); \
    { float a=MX3(C0[0],C0[1],C1[0]),b=MX3(C0[2],C0[3],C1[1]); a=MX3(a,C1[2],C1[3]); \
      _Pragma("unroll") for(int r=4;r<16;r+=4){a=MX3(a,C0[r],C0[r+1]);b=MX3(b,C0[r+2],C0[r+3]);a=MX3(a,C1[r],C1[r+1]);b=MX3(b,C1[r+2],C1[r+3]);} \
      float rm=__builtin_fmaxf(a,b); { auto rr=__builtin_amdgcn_permlane32_swap(__float_as_uint(rm),__float_as_uint(rm),false,false); rm=__builtin_fmaxf(__uint_as_float(rr[0]),__uint_as_float(rr[1])); } \
      resc=false; \
      if(__builtin_expect(__any(rm>(float)THRL),0)){ const float dl=__builtin_ceilf(__builtin_fmaxf(rm,0.f)); mhat+=dl; \
        _Pragma("unroll") for(int r=0;r<16;++r){C0[r]-=dl;C1[r]-=dl;} \
        SETM(); \
        const float f=__builtin_amdgcn_exp2f(-dl); l_reg*=f; if(hi==0)wsf[r32]=f; resc=true; } } \
    SBAR(); \
    GAPB2(o[0]=__builtin_amdgcn_mfma_f32_32x32x16_bf16(PAF(0),VFR(0),o[0],0,0,0), C0,0); VRD(0,0,2); SBAR(); \
    GAPB2(o[1]=__builtin_amdgcn_mfma_f32_32x32x16_bf16(PAF(0),VFR(1),o[1],0,0,0), C0,2); VRD(1,1,2); SBAR(); \
    GAPB2(o[2]=__builtin_amdgcn_mfma_f32_32x32x16_bf16(PAF(0),VFR(2),o[2],0,0,0), C0,4); VRD(2,2,2); SBAR(); \
    GAPB2(o[3]=__builtin_amdgcn_mfma_f32_32x32x16_bf16(PAF(0),VFR(3),o[3],0,0,0), C0,6); VRD(3,3,2); SBAR(); \
    GAPB2(o[0]=__builtin_amdgcn_mfma_f32_32x32x16_bf16(PAF(1),VFR(4),o[0],0,0,0), C0,8); VRD(4,0,3); SBAR(); \
    GAPB2(o[1]=__builtin_amdgcn_mfma_f32_32x32x16_bf16(PAF(1),VFR(5),o[1],0,0,0), C0,10); VRD(5,1,3); SBAR(); \
    GAPB2(o[2]=__builtin_amdgcn_mfma_f32_32x32x16_bf16(PAF(1),VFR(6),o[2],0,0,0), C0,12); VRD(6,2,3); SBAR(); \
    GAPB2(o[3]=__builtin_amdgcn_mfma_f32_32x32x16_bf16(PAF(1),VFR(7),o[3],0,0,0), C0,14); VRD(7,3,3); SBAR(); \
    KRD(GL,0); GAPB2(o[0]=__builtin_amdgcn_mfma_f32_32x32x16_bf16(PAF(2),VFR(0),o[0],0,0,0), C1,0); \
    KRD(GL,1); GAPB2(o[1]=__builtin_amdgcn_mfma_f32_32x32x16_bf16(PAF(2),VFR(1),o[1],0,0,0), C1,2); \
    KRD(GL,2); GAPB2(o[2]=__builtin_amdgcn_mfma_f32_32x32x16_bf16(PAF(2),VFR(2),o[2],0,0,0), C1,4); \
    KRD(GL,3); GAPB2(o[3]=__builtin_amdgcn_mfma_f32_32x32x16_bf16(PAF(2),VFR(3),o[3],0,0,0), C1,6); \
    GAPB2(o[0]=__builtin_amdgcn_mfma_f32_32x32x16_bf16(PAF(3),VFR(4),o[0],0,0,0), C1,8); \
    GAPB2(o[1]=__builtin_amdgcn_mfma_f32_32x32x16_bf16(PAF(3),VFR(5),o[1],0,0,0), C1,10); \
    GAPB2(o[2]=__builtin_amdgcn_mfma_f32_32x32x16_bf16(PAF(3),VFR(6),o[2],0,0,0), C1,12); \
    GAPB2(o[3]=__builtin_amdgcn_mfma_f32_32x32x16_bf16(PAF(3),VFR(7),o[3],0,0,0), C1,14); \
    }while(0)
  int t=1;
  #undef CMASK
  #define CMASK(P0,P1,t) do{}while(0)
  for(;t+5<NT;t+=2){
    STEP(pB0,pB1,pA0,pA1,t,true,true,true);     WAIT_BAR(3); RESC(); ROT();
    STEP(pA0,pA1,pB0,pB1,t+1,true,true,true);   WAIT_BAR(3); RESC(); ROT();
  }
  #undef CMASK
  #define CMASK(P0,P1,t) do{int jb_=(t)-(NT-4); if(jb_>=0)cmask(P0,P1,jb_,qrel,hi);}while(0)
  #define ENDW(tt) do{ if((tt)+3<NT){WAIT_BAR(3);} else if((tt)+2<NT){WAIT_BAR(2);} else {WAIT_BAR(0);} }while(0)
  for(;t+1<NT;t+=2){
    STEP(pB0,pB1,pA0,pA1,t,(t+3<NT),(t+1<NT),(t+1<NT));       ENDW(t);   RESC(); ROT();
    STEP(pA0,pA1,pB0,pB1,t+1,(t+4<NT),(t+2<NT),(t+2<NT));     ENDW(t+1); RESC(); ROT();
  }
  STEP(pB0,pB1,pA0,pA1,NT-1,false,false,false); RESC();
  { float sacc=pB0[0]+pB0[1]; _Pragma("unroll") for(int r=2;r<16;++r)sacc+=pB0[r]; _Pragma("unroll") for(int r=0;r<16;++r)sacc+=pB1[r]; l_reg+=sacc;
    pw0=(u32x4){PKW(pB0,0),PKW(pB0,2),PKW(pB0,4),PKW(pB0,6)};pw1=(u32x4){PKW(pB0,8),PKW(pB0,10),PKW(pB0,12),PKW(pB0,14)};pw2=(u32x4){PKW(pB1,0),PKW(pB1,2),PKW(pB1,4),PKW(pB1,6)};pw3=(u32x4){PKW(pB1,8),PKW(pB1,10),PKW(pB1,12),PKW(pB1,14)};
    SBAR(); pv(o,vb0+2*sl_cur,PAF(0),PAF(1),PAF(2),PAF(3)); }
  #undef PKW
  #undef PAF
  #undef VFR
  #undef PIN
  #undef MX3
  #undef GAPA
  #undef GAPB
  #undef GAPB2
  #undef EX
  #undef VRD
  #undef KRD
  #undef STEP
  #undef ENDW
  {auto rr=__builtin_amdgcn_permlane32_swap(__float_as_uint(l_reg),__float_as_uint(l_reg),false,false);l_reg=__uint_as_float(rr[0])+__uint_as_float(rr[1]);}
  if(hi==0)wsf[32+r32]=l_reg;asm volatile("s_waitcnt lgkmcnt(0)":::"memory");
  float rli[16];
  #pragma unroll
  for(int r=0;r<16;++r)rli[r]=__builtin_amdgcn_rcpf(wsf[32+crow(r,hi)]);
  bf16*Ow=O+(rowbase+q0+wid*QBLK)*OP;
  { bf16*stg=(bf16*)(shm+LDS_OST)+wid*4096;
    #pragma unroll
    for(int r=0;r<16;++r){const int orow=crow(r,hi);
      #pragma unroll
      for(int d0=0;d0<4;++d0)stg[orow*128+d0*32+r32]=__float2bfloat16(o[d0][r]*rli[r]);}
    asm volatile("s_waitcnt lgkmcnt(0)":::"memory");
    if(F_fmode==1){
      const __amdgpu_buffer_rsrc_t orr=__builtin_amdgcn_make_buffer_rsrc((void*)Ow,0,0x7fffffff,0x00020000);
      #pragma unroll
      for(int i=0;i<8;++i){const int row=i*4+(lane>>4),ch=lane&15; const u32x4 v=*(const u32x4*)(stg+row*128+ch*8); __builtin_amdgcn_raw_buffer_store_b128(v,orr,(unsigned)((row*OP+ch*8)*2),0,16);}
      asm volatile("s_waitcnt vmcnt(0) lgkmcnt(0)\n\ts_barrier":::"memory");
      if(tid==0)__hip_atomic_store(F_flag,1u,__ATOMIC_RELAXED,__HIP_MEMORY_SCOPE_AGENT);
    } else {
      if(tid==0){ unsigned sp_=0; while(__hip_atomic_load(F_flag,__ATOMIC_RELAXED,__HIP_MEMORY_SCOPE_AGENT)==0u){ __builtin_amdgcn_s_sleep(2); if(++sp_>(1u<<22))break; }
        __builtin_amdgcn_fence(__ATOMIC_ACQUIRE,"agent"); asm volatile("s_waitcnt vmcnt(0)":::"memory"); }
      asm volatile("s_waitcnt lgkmcnt(0)\n\ts_barrier":::"memory");
      const int ch=lane&15; const float*sgp=F_sg+8*ch; const float gs=F_gscale,lam=F_lam;
      const f32x4_t g0=*(const f32x4_t*)sgp*gs,g1=*(const f32x4_t*)(sgp+4)*gs;
      unsigned short*mo=F_mixo+(rowbase+q0+wid*QBLK)*1024;
      u32x4 pv_[8];
      #pragma unroll
      for(int i=0;i<8;++i){const int row=i*4+(lane>>4); pv_[i]=*(const u32x4*)(Ow+(long)row*OP+ch*8);}
      #pragma unroll
      for(int i=0;i<8;++i){const int row=i*4+(lane>>4); const u32x4 a=*(const u32x4*)(stg+row*128+ch*8),c=pv_[i];
        #define BLO(w) __uint_as_float((w)<<16)
        #define BHI(w) __uint_as_float((w)&0xffff0000u)
        const f32x4_t v0=(f32x4_t){BLO(a.x),BHI(a.x),BLO(a.y),BHI(a.y)}-lam*(f32x4_t){BLO(c.x),BHI(c.x),BLO(c.y),BHI(c.y)};
        const f32x4_t v1=(f32x4_t){BLO(a.z),BHI(a.z),BLO(a.w),BHI(a.w)}-lam*(f32x4_t){BLO(c.z),BHI(c.z),BLO(c.w),BHI(c.w)};
        #undef BLO
        #undef BHI
        float sq=(v0[0]*v0[0]+v0[1]*v0[1])+(v0[2]*v0[2]+v0[3]*v0[3])+(v1[0]*v1[0]+v1[1]*v1[1])+(v1[2]*v1[2]+v1[3]*v1[3]);
        #pragma unroll
        for(int m_=1;m_<16;m_<<=1) sq+=__builtin_bit_cast(float,__builtin_amdgcn_ds_bpermute((lane^m_)<<2,__builtin_bit_cast(int,sq)));
        const float rstd=__builtin_amdgcn_rsqf(sq*(1.0f/128.0f)+1e-5f);
        const f32x4_t o0=v0*rstd*g0,o1=v1*rstd*g1;
        u32x4 w; w.x=cvtpk_s(o0[0],o0[1]); w.y=cvtpk_s(o0[2],o0[3]); w.z=cvtpk_s(o1[0],o1[1]); w.w=cvtpk_s(o1[2],o1[3]);
        *(u32x4*)(mo+(long)row*1024+ch*8)=w; }
      asm volatile("s_waitcnt lgkmcnt(0)\n\ts_barrier":::"memory");
    } }
  #undef DMA_K
  #undef TRB
  #undef SETM
  #undef KBIAS
  #undef BIASC
  #undef DMA_V
  #undef CMASK
  #undef START
  #undef RESC
  #undef ROT
}
constexpr int ATTN_LDS_BYTES=LDS_BYTES;
#undef SBAR
#undef WAIT_BAR
}

namespace sgu {
constexpr int SP = 136;
constexpr int HALF_LDS = 128 * SP * 2 + 512;
__device__ __forceinline__ void unit2(LAS unsigned char* lds, const bf16_t* z, bf16_t* mix, const float* ln_g, const float* ln_b, const float* w_s, const float* b_s, int itA, int itB) {
    int tid_ = threadIdx.x; asm volatile("" : "+v"(tid_));
    const int tid = tid_, lane = tid & 63, r32 = lane & 31, hi = lane >> 5; const int wid = __builtin_amdgcn_readfirstlane(tid >> 6);
    const int half = wid >> 2, tl = tid & 255, tb = wid & 3;
    const int it = half ? itB : itA; const bool act = it >= 0;
    const int chunk = act ? it >> 2 : 0, g = act ? it & 3 : 0;
    const size_t row0 = (size_t)chunk * 128;
    LAS bf16_t* Vt = (LAS bf16_t*)(lds + half * HALF_LDS);
    const int t = 32 * tb + r32, nks = 2 * tb + 2;
    const float* wrow = w_s + ((size_t)g * 128 + t) * 128 + 8 * hi;
    f32x4 wa[8], wb[8];
#pragma unroll
    for (int ks = 0; ks < 8; ++ks) { if (act && ks < nks) { wa[ks] = *(const f32x4*)(wrow + 16 * ks); wb[ks] = *(const f32x4*)(wrow + 16 * ks + 4); } else { wa[ks] = (f32x4){0.f, 0.f, 0.f, 0.f}; wb[ks] = wa[ks]; } }
    const float bias = b_s[g * 128 + t];
    const bf16_t* up = z + (row0 + t) * DIN + 1536 + g * 128 + 4 * hi; bf16_t* op = mix + (row0 + t) * D + 512 + g * 128 + 4 * hi;
    if (act) {
        const int s = tl >> 1, qd = tl & 1; const bf16_t* src = z + (row0 + s) * DIN + 2048 + g * 128 + 64 * qd;
        float v[64]; float sum = 0.f;
#pragma unroll
        for (int j = 0; j < 8; ++j) { const u32x4 w = *(const u32x4*)(src + 8 * j);
#pragma unroll
            for (int e = 0; e < 4; ++e) { const float a = gelu_t(bflo(w[e])), c = gelu_t(bfhi(w[e])); v[8 * j + 2 * e] = a; v[8 * j + 2 * e + 1] = c; sum += a + c; } }
        sum += shx(sum, 1, lane);
        const float mean = sum * (1.0f / 128.0f); float sq = 0.f;
#pragma unroll
        for (int j = 0; j < 64; ++j) { v[j] -= mean; sq += v[j] * v[j]; }
        sq += shx(sq, 1, lane);
        const float rstd = __builtin_amdgcn_rsqf(sq * (1.0f / 128.0f) + LN_EPS);
        const float* gp = ln_g + g * 128 + 64 * qd; const float* bp = ln_b + g * 128 + 64 * qd;
#pragma unroll
        for (int j = 0; j < 64; ++j) Vt[(64 * qd + j) * SP + s] = (bf16_t)f2bf(v[j] * rstd * gp[j] + bp[j]);
    }
    __syncthreads();
    if (act) {
        f32x16 acc[4]; acc[0] = f32x16{}; acc[1] = f32x16{}; acc[2] = f32x16{}; acc[3] = f32x16{};
#pragma unroll
        for (int ks = 0; ks < 8; ++ks) if (ks < nks) {
            const int s0 = 16 * ks + 8 * hi;
            u32x4 w; w.x = pk2(s0 <= t ? wa[ks][0] : 0.f, s0 + 1 <= t ? wa[ks][1] : 0.f); w.y = pk2(s0 + 2 <= t ? wa[ks][2] : 0.f, s0 + 3 <= t ? wa[ks][3] : 0.f);
            w.z = pk2(s0 + 4 <= t ? wb[ks][0] : 0.f, s0 + 5 <= t ? wb[ks][1] : 0.f); w.w = pk2(s0 + 6 <= t ? wb[ks][2] : 0.f, s0 + 7 <= t ? wb[ks][3] : 0.f);
            const bf16x8 bfrag = __builtin_bit_cast(bf16x8, w);
#pragma unroll
            for (int cc = 0; cc < 4; ++cc) { const bf16x8 af = *(const LAS bf16x8*)(Vt + (32 * cc + r32) * SP + 16 * ks + 8 * hi);
                acc[cc] = __builtin_amdgcn_mfma_f32_32x32x16_bf16(af, bfrag, acc[cc], 0, 0, 0); }
        }
#pragma unroll
        for (int cc = 0; cc < 4; ++cc) {
            u32x2 uw[4];
#pragma unroll
            for (int q4 = 0; q4 < 4; ++q4) uw[q4] = *(const u32x2*)(up + 32 * cc + 8 * q4);
#pragma unroll
            for (int q4 = 0; q4 < 4; ++q4) { const u32x2 u2 = uw[q4];
                const float o0 = gelu_t(bflo(u2.x)) * (acc[cc][4 * q4] + bias), o1 = gelu_t(bfhi(u2.x)) * (acc[cc][4 * q4 + 1] + bias);
                const float o2 = gelu_t(bflo(u2.y)) * (acc[cc][4 * q4 + 2] + bias), o3 = gelu_t(bfhi(u2.y)) * (acc[cc][4 * q4 + 3] + bias);
                u32x2 w; w.x = cvtpk(o0, o1); w.y = cvtpk(o2, o3); *(u32x2*)(op + 32 * cc + 8 * q4) = w; }
        }
    }
    __syncthreads();
}
constexpr int QUARTER_LDS = 128 * SP * 2 + 512;
__device__ __forceinline__ void unit4(LAS unsigned char* lds, const bf16_t* z, bf16_t* mix, const float* ln_g, const float* ln_b, const float* w_s, const float* b_s, int it0, int it1, int it2, int it3) {
    int tid_ = threadIdx.x; asm volatile("" : "+v"(tid_));
    const int tid = tid_, lane = tid & 63, r32 = lane & 31, hi = lane >> 5; const int wid = __builtin_amdgcn_readfirstlane(tid >> 6);
    const int qt = wid >> 1, wq = wid & 1, tq = tid & 127;
    const int it = qt == 0 ? it0 : qt == 1 ? it1 : qt == 2 ? it2 : it3; const bool act = it >= 0;
    const int chunk = act ? it >> 2 : 0, g = act ? it & 3 : 0;
    const size_t row0 = (size_t)chunk * 128;
    LAS bf16_t* Vt = (LAS bf16_t*)(lds + qt * QUARTER_LDS);
    if (act) {
        const bf16_t* src = z + (row0 + tq) * DIN + 2048 + g * 128;
        unsigned vp[64]; float sum = 0.f, sq = 0.f;
#pragma unroll
        for (int j = 0; j < 16; ++j) { const u32x4 w = *(const u32x4*)(src + 8 * j);
#pragma unroll
            for (int e = 0; e < 4; ++e) { const f32x2 gv = gelu_t2((f32x2){bflo(w[e]), bfhi(w[e])}); vp[4 * j + e] = cvtpk(gv.x, gv.y); sum += gv.x + gv.y; sq += gv.x * gv.x + gv.y * gv.y; } }
        const float mean = sum * (1.0f / 128.0f);
        const float rstd = __builtin_amdgcn_rsqf(fmaxf(sq * (1.0f / 128.0f) - mean * mean, 0.f) + LN_EPS);
        const float* gp = ln_g + g * 128; const float* bp = ln_b + g * 128;
#pragma unroll
        for (int j = 0; j < 64; ++j) { const f32x2 nv = (((f32x2){bflo(vp[j]), bfhi(vp[j])} - mean) * rstd) * (f32x2){gp[2 * j], gp[2 * j + 1]} + (f32x2){bp[2 * j], bp[2 * j + 1]};
            const unsigned w = cvtpk(nv.x, nv.y);
            Vt[(2 * j) * SP + tq] = (bf16_t)(w & 0xffffu); Vt[(2 * j + 1) * SP + tq] = (bf16_t)(w >> 16); }
    }
    __syncthreads();
    if (act) {
#pragma unroll
        for (int pass = 0; pass < 2; ++pass) {
            const int tb = pass == 0 ? (wq ? 1 : 0) : (wq ? 2 : 3); const int t = 32 * tb + r32, nks = 2 * tb + 2;
            const float* wrow = w_s + ((size_t)g * 128 + t) * 128 + 8 * hi;
            f32x4 wa[8], wb[8];
#pragma unroll
            for (int ks = 0; ks < 8; ++ks) { if (ks < nks) { wa[ks] = *(const f32x4*)(wrow + 16 * ks); wb[ks] = *(const f32x4*)(wrow + 16 * ks + 4); } else { wa[ks] = (f32x4){0.f, 0.f, 0.f, 0.f}; wb[ks] = wa[ks]; } }
            const float bias = b_s[g * 128 + t];
            const bf16_t* up = z + (row0 + t) * DIN + 1536 + g * 128 + 4 * hi; bf16_t* op = mix + (row0 + t) * D + 512 + g * 128 + 4 * hi;
            u32x2 uw[16];
#pragma unroll
            for (int j = 0; j < 16; ++j) uw[j] = *(const u32x2*)(up + 8 * j);
            f32x16 acc[4]; acc[0] = f32x16{}; acc[1] = f32x16{}; acc[2] = f32x16{}; acc[3] = f32x16{};
#pragma unroll
            for (int ks = 0; ks < 8; ++ks) if (ks < nks) {
                const int s0 = 16 * ks + 8 * hi;
                u32x4 w; w.x = pk2(s0 <= t ? wa[ks][0] : 0.f, s0 + 1 <= t ? wa[ks][1] : 0.f); w.y = pk2(s0 + 2 <= t ? wa[ks][2] : 0.f, s0 + 3 <= t ? wa[ks][3] : 0.f);
                w.z = pk2(s0 + 4 <= t ? wb[ks][0] : 0.f, s0 + 5 <= t ? wb[ks][1] : 0.f); w.w = pk2(s0 + 6 <= t ? wb[ks][2] : 0.f, s0 + 7 <= t ? wb[ks][3] : 0.f);
                const bf16x8 bfrag = __builtin_bit_cast(bf16x8, w);
#pragma unroll
                for (int cc = 0; cc < 4; ++cc) { const bf16x8 af = *(const LAS bf16x8*)(Vt + (32 * cc + r32) * SP + 16 * ks + 8 * hi);
                    acc[cc] = __builtin_amdgcn_mfma_f32_32x32x16_bf16(af, bfrag, acc[cc], 0, 0, 0); }
            }
#pragma unroll
            for (int cc = 0; cc < 4; ++cc)
#pragma unroll
                for (int q4 = 0; q4 < 4; ++q4) { const u32x2 u2 = uw[4 * cc + q4];
                    const f32x2 oa = gelu_t2((f32x2){bflo(u2.x), bfhi(u2.x)}) * ((f32x2){acc[cc][4 * q4], acc[cc][4 * q4 + 1]} + bias);
                    const f32x2 ob = gelu_t2((f32x2){bflo(u2.y), bfhi(u2.y)}) * ((f32x2){acc[cc][4 * q4 + 2], acc[cc][4 * q4 + 3]} + bias);
                    u32x2 w; w.x = cvtpk(oa.x, oa.y); w.y = cvtpk(ob.x, ob.y); *(u32x2*)(op + 32 * cc + 8 * q4) = w; }
        }
    }
    __syncthreads();
}
}
constexpr int CV_IN = (D / 64) * (DIN / 32), CV_OUT = (D / 64) * (D / 32), CV_UP = (D / 64) * (NUP / 32), CV_DN = (DFF / 64) * (D / 32), CV_L = CV_IN + CV_OUT + CV_UP + CV_DN;
struct CvPtrs { const float *w_in, *norm1_g, *w_out, *w_up, *norm2_g, *w_down; };
__device__ __forceinline__ void cv_desc(int gi, const float* w_in, const float* norm1_g, const float* w_out, const float* w_up, const float* norm2_g, const float* w_down, unsigned char* ws,
                                        const float*& W, const float*& gk, bf16_t*& WT, int& K, int& N, int& k0, int& n0, int& mode) {
    const int l = gi / CV_L; int r = gi % CV_L; unsigned char* wl = ws + WS_W + l * W_LAYER;
    if (r < CV_IN) { W = w_in + (size_t)l * D * DIN; gk = norm1_g + l * D; WT = (bf16_t*)(wl + W_IN); K = D; N = DIN; mode = 1; }
    else if ((r -= CV_IN) < CV_OUT) { W = w_out + (size_t)l * D * D; gk = nullptr; WT = (bf16_t*)(wl + W_OUT); K = D; N = D; mode = 0; }
    else if ((r -= CV_OUT) < CV_UP) { W = w_up + (size_t)l * D * NUP; gk = norm2_g + l * D; WT = (bf16_t*)(wl + W_UP); K = D; N = NUP; mode = 2; }
    else { r -= CV_UP; W = w_down + (size_t)l * DFF * D; gk = nullptr; WT = (bf16_t*)(wl + W_DOWN); K = DFF; N = D; mode = 0; }
    const int nblk = N / 32; k0 = 64 * (r / nblk); n0 = 32 * (r % nblk);
}
__device__ __forceinline__ void cv_load(float (&wv)[32], const float* W, int N, int k0, int n0, int lane) {
#pragma unroll
    for (int i = 0; i < 32; ++i) wv[i] = __builtin_nontemporal_load(W + (size_t)(k0 + 2 * i + (lane >> 5)) * N + n0 + (lane & 31));
}
__device__ __forceinline__ void cv_finish(const float (&wv)[32], const float* gk, bf16_t* WT, int K, int k0, int n0, int mode, LAS float* scr, int lane) {
    const float cs = (mode == 1 && n0 < 512) ? QSCALE : 1.0f;
#pragma unroll
    for (int i = 0; i < 32; ++i) { const int kk = 2 * i + (lane >> 5); float v = wv[i];
        if (mode != 0) v *= gk[k0 + kk] * cs;
        scr[kk * 33 + (lane & 31)] = v; }
    asm volatile("s_waitcnt lgkmcnt(0)" ::: "memory");
    const int c = lane & 7;
    int d0 = n0;
    if (mode == 2) { const int half = n0 >= DFF ? 1 : 0, cc = n0 - half * DFF; d0 = 256 * (cc >> 7) + 128 * half + (cc & 127); }
#pragma unroll
    for (int j = 0; j < 4; ++j) { const int n = (lane >> 3) + 8 * j; const LAS float* s = scr + (8 * c) * 33 + n;
        u32x4 o; o.x = pk2(s[0 * 33], s[1 * 33]); o.y = pk2(s[2 * 33], s[3 * 33]); o.z = pk2(s[4 * 33], s[5 * 33]); o.w = pk2(s[6 * 33], s[7 * 33]);
        *(u32x4*)(WT + (size_t)(d0 + n) * K + k0 + 8 * c) = o; }
    asm volatile("s_waitcnt lgkmcnt(0)" ::: "memory");
}
__device__ __forceinline__ void convert_weights(const float* w_in, const float* norm1_g, const float* w_out, const float* w_up, const float* norm2_g, const float* w_down, unsigned char* ws, LAS float* scr, int lane, int first, int stride, int total) {
    if (first >= total) return;
    const float *W, *gk; bf16_t* WT; int K, N, k0, n0, mode; float wv[32];
    cv_desc(first, w_in, norm1_g, w_out, w_up, norm2_g, w_down, ws, W, gk, WT, K, N, k0, n0, mode);
    cv_load(wv, W, N, k0, n0, lane);
    for (int gi = first;;) {
        const int g2 = gi + stride; const bool has = g2 < total;
        const float *W2 = W, *gk2 = gk; bf16_t* WT2 = WT; int K2 = K, N2 = N, k02 = k0, n02 = n0, mode2 = mode; float wv2[32];
        if (has) { cv_desc(g2, w_in, norm1_g, w_out, w_up, norm2_g, w_down, ws, W2, gk2, WT2, K2, N2, k02, n02, mode2); cv_load(wv2, W2, N2, k02, n02, lane); }
        cv_finish(wv, gk, WT, K, k0, n0, mode, scr, lane);
        if (!has) break;
        W = W2; gk = gk2; WT = WT2; K = K2; N = N2; k0 = k02; n0 = n02; mode = mode2; gi = g2;
#pragma unroll
        for (int i = 0; i < 32; ++i) wv[i] = wv2[i];
    }
}

#define XB_TMO      128
#define XB_XCNT(j)  (256  + 64 * (j))
#define XB_XSUB(j)  (1280 + 64 * (j))
#define XB_XGEN(j)  (2304 + 64 * (j))
#define XB_TOP      3328
#define XB_TOPGEN   3392
#define XCD_BAR_WORDS 3456
#define XB_SPIN_CAP (1u << 18)

__device__ __forceinline__ unsigned xb_ld(unsigned* p)              { return __hip_atomic_load(p, __ATOMIC_RELAXED, __HIP_MEMORY_SCOPE_AGENT); }
__device__ __forceinline__ unsigned xb_add(unsigned* p, unsigned v) { return __hip_atomic_fetch_add(p, v, __ATOMIC_RELAXED, __HIP_MEMORY_SCOPE_AGENT); }
__device__ __forceinline__ unsigned xb_xcc_id() { return (unsigned)__builtin_amdgcn_s_getreg((3 << 11) | 20) & 0xFu; }
#define XB_SPIN(cond, bar) do { unsigned _sp = 0; while (cond) { __builtin_amdgcn_s_sleep(1); \
    if ((++_sp & 255u) == 0u) { if (xb_ld(&(bar)[XB_TMO])) break; if (_sp > XB_SPIN_CAP) { atomicAdd(&(bar)[XB_TMO], 1u); break; } } } } while (0)

struct XcdBarrier {
    unsigned* bar; unsigned x;
    volatile LAS unsigned* st;
};

__device__ __forceinline__ XcdBarrier xcd_barrier_post(unsigned* bar, volatile LAS unsigned* st) {
    XcdBarrier b; b.bar = bar; b.x = xb_xcc_id(); b.st = st;
    if (threadIdx.x == 0) (void)xb_add(&bar[XB_XCNT(b.x)], 1u);
    return b;
}
__device__ __forceinline__ void xcd_barrier_complete(unsigned* bar, unsigned x, unsigned& nloc, unsigned& nx) {
    const unsigned G = gridDim.x * gridDim.y * gridDim.z;
    unsigned sum, cnt, mine, sp = 0u;
    for (;;) {
        sum = 0u; cnt = 0u; mine = 0u;
#pragma unroll
        for (unsigned j = 0; j < 16; ++j) { const unsigned c = xb_ld(&bar[XB_XCNT(j)]); sum += c; cnt += (c > 0u) ? 1u : 0u; mine = (j == x) ? c : mine; }
        if (sum == G) break;
        __builtin_amdgcn_s_sleep(1);
        if ((++sp & 255u) == 0u) { if (xb_ld(&bar[XB_TMO])) break; if (sp > XB_SPIN_CAP) { atomicAdd(&bar[XB_TMO], 1u); break; } }
    }
    nloc = mine > 0u ? mine : 1u; nx = cnt > 0u ? cnt : 1u;
}

__device__ __forceinline__ void xcd_barrier(const XcdBarrier& b) {
    asm volatile("s_waitcnt vmcnt(0)" ::: "memory");
    __syncthreads();
    if (threadIdx.x == 0) {
        unsigned* bar = b.bar;
        __builtin_amdgcn_s_waitcnt(0);
        unsigned nloc = b.st[0], nx = b.st[1];
        if (nloc == 0u) { xcd_barrier_complete(bar, b.x, nloc, nx); b.st[0] = nloc; b.st[1] = nx; }
        const unsigned old = xb_add(&bar[XB_XSUB(b.x)], 1u);
        const unsigned gen = old / nloc;
        if (old + 1u == (gen + 1u) * nloc) {
            __builtin_amdgcn_fence(__ATOMIC_RELEASE, "agent");
            asm volatile("s_waitcnt vmcnt(0)" ::: "memory");
            const unsigned og = xb_add(&bar[XB_TOP], 1u);
            const unsigned tg = og / nx;
            if (og + 1u == (tg + 1u) * nx) xb_add(&bar[XB_TOPGEN], 1u);
            else XB_SPIN(xb_ld(&bar[XB_TOPGEN]) == tg, bar);
            __builtin_amdgcn_fence(__ATOMIC_ACQUIRE, "agent");
            xb_add(&bar[XB_XGEN(b.x)], 1u);
            asm volatile("s_waitcnt vmcnt(0)" ::: "memory");
        } else {
            XB_SPIN(xb_ld(&bar[XB_XGEN(b.x)]) == gen, bar);
            __builtin_amdgcn_fence(__ATOMIC_ACQUIRE, "agent");
            asm volatile("s_waitcnt vmcnt(0)" ::: "memory");
        }
    }
    __syncthreads();
}

struct Params {
    const float *x, *norm1_g, *w_in, *lam_q1, *lam_k1, *lam_q2, *lam_k2, *subln_g, *sgu_ln_g, *sgu_ln_b, *sgu_w, *sgu_b, *w_out, *norm2_g, *ffn_w_up, *ffn_conv_w, *ffn_conv_b, *ffn_w_down, *final_g;
    float* out; unsigned char* ws;
};

#define CAS __attribute__((address_space(4)))
#define LOADP() const CAS Params* pp = (const CAS Params*)__builtin_amdgcn_kernarg_segment_ptr(); asm volatile("" : "+s"(pp)); unsigned char* ws = pp->ws; float* ss = (float*)(ws + WS_SS)
#define GRID_BAR() do { const CAS Params* ppb = (const CAS Params*)__builtin_amdgcn_kernarg_segment_ptr(); asm volatile("" : "+s"(ppb)); XcdBarrier b_; b_.bar = (unsigned*)(ppb->ws + WS_CTL); b_.x = xb_xcc_id(); \
        b_.st = (volatile LAS unsigned*)((LAS unsigned char*)lds_raw + LDS_BYTES - 64); xcd_barrier(b_); } while (0)

template <int l> __device__ __forceinline__ void layer_body(LAS unsigned char* lds, unsigned char* lds_raw, const int G, const int bx, const int vcu) {
#if PH & 1
        {
            LOADP(); unsigned char* wl = ws + WS_W + l * W_LAYER;
            pg8::Gemm g{(const bf16_t*)(ws + WS_XB), (const bf16_t*)(wl + W_IN), M, DIN, D, 256, 128, 0};
            int Gl = G, bxl = bx; asm volatile("" : "+s"(Gl), "+s"(bxl));
            const bool fused = FUSE_SGU && (Gl == 256);
            unsigned* cnt = (unsigned*)(ws + WS_CTL) + 8192 + 64 * l;
            InProjOrder S; S.init(G, bx, cnt, fused);
            fill_rstd<false>(lds, S, ss);
            EpiInProj E{(bf16_t*)(ws + WS_Z), (LAS const float*)(lds + RSTAB_OFF), fused};
            for (int rep = 0; rep < REP_P1; ++rep) pg8::gemm_phase<EpiInProj, InProjOrder, true, true>(lds, g, S, E);
            if (fused && bxl >= 128) {
                if (threadIdx.x == 0) { unsigned sp = 0;
                    while (__hip_atomic_load(cnt, __ATOMIC_RELAXED, __HIP_MEMORY_SCOPE_AGENT) < 256u * REP_P1) { __builtin_amdgcn_s_sleep(2); if (++sp > (1u << 22)) break; }
                    __builtin_amdgcn_fence(__ATOMIC_ACQUIRE, "agent"); asm volatile("s_waitcnt vmcnt(0)" ::: "memory"); }
                __syncthreads();
                const bf16_t* zb = (const bf16_t*)(ws + WS_Z); bf16_t* mix = (bf16_t*)(ws + WS_MIX);
                { const int it = bxl - 128; sgu::unit4(lds, zb, mix, pp->sgu_ln_g + l * 512, pp->sgu_ln_b + l * 512, pp->sgu_w + (size_t)l * 4 * 128 * 128, pp->sgu_b + l * 512, it, it + 128, it + 256, it + 384); }
            }
        }
        GRID_BAR();
#endif
#if PH & 2
        {
            LOADP(); (void)ss; int tid = threadIdx.x; asm volatile("" : "+v"(tid)); const int lane = tid & 63;
            const attn_body::bf16* z = (const attn_body::bf16*)(ws + WS_Z); attn_body::bf16* opart = (attn_body::bf16*)(ws + WS_OP1);
            const int bhr = vcu >> 4, s16 = vcu & 15, b = bhr >> 3, h = (bhr >> 1) & 3, br = bhr & 1;
            const float slope2 = exp2f(-2.0f * (float)(h + 1)) * LOG2E;
            const float lam_init = 0.8f - 0.6f * expf(-0.3f * (float)l);
            const float d1 = wave_sum(pp->lam_q1[l * 64 + lane] * pp->lam_k1[l * 64 + lane], lane), d2 = wave_sum(pp->lam_q2[l * 64 + lane] * pp->lam_k2[l * 64 + lane], lane);
            const float lam = __builtin_bit_cast(float, __builtin_amdgcn_readfirstlane(__builtin_bit_cast(int, expf(d1) - expf(d2) + lam_init)));
            unsigned* flags = (unsigned*)(ws + WS_CTL) + 9216 + ((l * 8 + b * 4 + h) * 32) * 16;
            if (vcu < 256)
                for (int i = 0; i < 2 * REP_ATT; ++i) { const int qb = (i & 1) ? 31 - s16 : s16;
                    attn_body::attn_unit<8>(b, qb, z + h * 128 + br * 64, z + 512 + h * 128 + br * 64, z + 1024 + h * 128, opart + h * 128, (char*)lds_raw, slope2, br, flags + qb * 16, (unsigned short*)(ws + WS_MIX) + h * 128, lam, 1.0f - lam_init, pp->subln_g + l * 128); }
        }
        GRID_BAR();
#endif
#if PH & 4
        {
            LOADP(); (void)ss;
            const bf16_t* zb = (const bf16_t*)(ws + WS_Z); bf16_t* mix = (bf16_t*)(ws + WS_MIX);
            int Gl = G; asm volatile("" : "+s"(Gl));
            if (!FUSE_SGU || Gl != 256) {
                for (int rs_ = 0; rs_ < REP_SGU * REP_P2B; ++rs_)
                for (int it = vcu; it < 512; it += 2 * G) sgu::unit2(lds, zb, mix, pp->sgu_ln_g + l * 512, pp->sgu_ln_b + l * 512, pp->sgu_w + (size_t)l * 4 * 128 * 128, pp->sgu_b + l * 512, it, it + G < 512 ? it + G : -1);
                GRID_BAR();
            }
        }
#endif
#if PH & 8
        {
            LOADP(); unsigned char* wl = ws + WS_W + l * W_LAYER;
            pg8::Gemm g{(const bf16_t*)(ws + WS_MIX), (const bf16_t*)(wl + W_OUT), M, D, D, 256, 128, 0}; pg8::StaticOrder S; S.init(M, D, G, bx);
            EpiRes E{nullptr, (bf16_t*)(ws + WS_XB), ss};
            pg8::gemm_phase<EpiRes, pg8::StaticOrder, true, true>(lds, g, S, E);
        }
        GRID_BAR();
#endif
#if PH & 16
        {
            LOADP(); unsigned char* wl = ws + WS_W + l * W_LAYER;
            pg8::Gemm g{(const bf16_t*)(ws + WS_XB) - 2 * D, (const bf16_t*)(wl + W_UP), P4_TILES * 256, NUP, D, P4_ROWS, P4_ROWS / 2, 2}; pg8::StaticOrder S; S.init(P4_TILES * 256, NUP, G, bx);
            fill_rstd<true>(lds, S, ss);
            EpiConvGate E{(bf16_t*)(ws + WS_Y), (LAS const float*)(lds + RSTAB_OFF), pp->ffn_conv_w + (size_t)l * 3 * NUP, pp->ffn_conv_b + (size_t)l * NUP};
            for (int rep = 0; rep < REP_P4; ++rep) pg8::gemm_phase<EpiConvGate, pg8::StaticOrder, true, true>(lds, g, S, E);
        }
        GRID_BAR();
#endif
#if PH & 32
        {
            LOADP(); unsigned char* wl = ws + WS_W + l * W_LAYER;
            pg8::Gemm g{(const bf16_t*)(ws + WS_Y), (const bf16_t*)(wl + W_DOWN), M, D, DFF, 256, 128, 0}; pg8::StaticOrder S; S.init(M, D, G, bx);
            int Gl = G; asm volatile("" : "+s"(Gl));
            if (l == DEPTH - 1 && Gl == 256) {
                EpiResFinal E{(const bf16_t*)(ws + WS_XB), ss, pp->out, pp->final_g, (unsigned*)(ws + WS_CTL) + 20480, (LAS float*)(lds + RSTAB_OFF)};
                pg8::gemm_phase<EpiResFinal, pg8::StaticOrder, true, true>(lds, g, S, E);
            } else {
                EpiRes E{nullptr, (bf16_t*)(ws + WS_XB), ss};
                pg8::gemm_phase<EpiRes, pg8::StaticOrder, true, true>(lds, g, S, E);
                GRID_BAR();
            }
        }
#endif
}

__global__ void __launch_bounds__(512, 2) fwd_megakernel(Params Punused) {
    extern __shared__ __attribute__((aligned(16))) unsigned char lds_raw[];
    LAS unsigned char* lds = (LAS unsigned char*)lds_raw;
    cg::grid_group grid = cg::this_grid();
    const int G = gridDim.x, bx = blockIdx.x;
    const int vcu = (G % 8 == 0) ? (bx % 8) * (G / 8) + bx / 8 : bx;
    volatile LAS unsigned* bst = (volatile LAS unsigned*)(lds + LDS_BYTES - 64);
    if (threadIdx.x < 2) bst[threadIdx.x] = 0u;
    __syncthreads();
    { const CAS Params* pp0 = (const CAS Params*)__builtin_amdgcn_kernarg_segment_ptr(); (void)xcd_barrier_post((unsigned*)(pp0->ws + WS_CTL), bst); }
    {
        LOADP(); int tid = threadIdx.x; asm volatile("" : "+v"(tid)); const int lane = tid & 63, wave = __builtin_amdgcn_readfirstlane(tid >> 6), gw = vcu * 8 + wave, NGW = G * 8;
        bf16_t* xb = (bf16_t*)(ws + WS_XB);
        LAS float* scr = (LAS float*)(lds + wave * 16384);
        for (int rep = 0; rep < REP_P0; ++rep) {
        convert_weights(pp->w_in, pp->norm1_g, pp->w_out, pp->ffn_w_up, pp->norm2_g, pp->ffn_w_down, ws, scr, lane, gw, NGW, DEPTH * CV_L);
        const float* x = pp->x;
        for (int m0 = gw; m0 < M; m0 += 2 * NGW) {
            f32x4 v[2][4];
#pragma unroll
            for (int k = 0; k < 2; ++k) { const f32x4* xr = (const f32x4*)(x + (size_t)(m0 + k * NGW) * D) + lane;
#pragma unroll
                for (int j = 0; j < 4; ++j) v[k][j] = __builtin_nontemporal_load(xr + 64 * j); }
#pragma unroll
            for (int k = 0; k < 2; ++k) { const int m = m0 + k * NGW; float s = 0.f;
                unsigned long long* o8 = (unsigned long long*)(xb + (size_t)m * D) + lane;
#pragma unroll
                for (int j = 0; j < 4; ++j) { const f32x4 t = v[k][j]; s += (t[0] * t[0] + t[1] * t[1]) + (t[2] * t[2] + t[3] * t[3]);
                    o8[64 * j] = (unsigned long long)pk2(t[0], t[1]) | ((unsigned long long)pk2(t[2], t[3]) << 32); }
                s = wave_sum(s, lane);
                if (lane < 16) ss[(size_t)m * 16 + lane] = lane == 0 ? s : 0.f; }
        }
        }
    }
    if (gridDim.y == 7u) grid.sync();
    GRID_BAR();
    for (int rep = 0; rep < REP_SYNC; ++rep) GRID_BAR();

    layer_body<0>(lds, lds_raw, G, bx, vcu);
    layer_body<1>(lds, lds_raw, G, bx, vcu);
    if (G != 256) {
        LOADP(); int tid = threadIdx.x; asm volatile("" : "+v"(tid)); const int lane = tid & 63, wave = __builtin_amdgcn_readfirstlane(tid >> 6), gw = vcu * 8 + wave, NGW = G * 8;
        float* out = pp->out; const f32x4* gp = (const f32x4*)pp->final_g + lane;
        const bf16_t* xb = (const bf16_t*)(ws + WS_XB);
        f32x4 gv[4];
#pragma unroll
        for (int j = 0; j < 4; ++j) gv[j] = gp[64 * j];
        for (int m0 = gw; m0 < M; m0 += 2 * NGW) {
            u32x2 xv[2][4]; float rs[2];
#pragma unroll
            for (int k = 0; k < 2; ++k) { const int m = m0 + k * NGW; const u32x2* xr = (const u32x2*)(xb + (size_t)m * D) + lane;
#pragma unroll
                for (int j = 0; j < 4; ++j) xv[k][j] = xr[64 * j];
                rs[k] = row_rstd(ss, m, NORM_EPS); }
#pragma unroll
            for (int k = 0; k < 2; ++k) { const int m = m0 + k * NGW; f32x4* xr = (f32x4*)(out + (size_t)m * D) + lane;
#pragma unroll
                for (int j = 0; j < 4; ++j) xr[64 * j] = (f32x4){bflo(xv[k][j].x), bfhi(xv[k][j].x), bflo(xv[k][j].y), bfhi(xv[k][j].y)} * rs[k] * gv[j]; }
        }
    }
}

extern "C" void kernel_launch(void* const* d_in, const int* in_sizes, int n_in, void* d_out, int out_size, void* d_ws, size_t ws_size, hipStream_t stream) {
    static int grid = 0;
    if (grid == 0) {
        if (n_in != 19 || in_sizes[0] != M * D || out_size != M * D || ws_size < WS_END) { fprintf(stderr, "kernel_launch: unexpected shapes (n_in %d, ws %zu)\n", n_in, ws_size); grid = -1; return; }
        int dev = 0, cus = 0, per_cu = 0;
        hipGetDevice(&dev); hipDeviceGetAttribute(&cus, hipDeviceAttributeMultiprocessorCount, dev);
        if (hipFuncSetAttribute((const void*)fwd_megakernel, hipFuncAttributeMaxDynamicSharedMemorySize, LDS_BYTES) != hipSuccess) { fprintf(stderr, "kernel_launch: hipFuncSetAttribute failed\n"); grid = -1; return; }
        if (hipOccupancyMaxActiveBlocksPerMultiprocessor(&per_cu, (const void*)fwd_megakernel, 512, LDS_BYTES) != hipSuccess || per_cu < 1) { fprintf(stderr, "kernel_launch: occupancy query gave %d\n", per_cu); per_cu = 1; }
        (void)hipGetLastError();
        grid = cus;
    }
    if (grid < 0) return;
    if (hipMemsetAsync((char*)d_ws + WS_CTL, 0, CTL_BYTES, stream) != hipSuccess) { fprintf(stderr, "kernel_launch: memset failed\n"); return; }
    Params p{};
    const float** f = (const float**)&p;
    for (int i = 0; i < 19; ++i) f[i] = (const float*)d_in[i];
    p.out = (float*)d_out; p.ws = (unsigned char*)d_ws;
    void* args[] = {&p};
    const hipError_t e = hipLaunchCooperativeKernel((const void*)fwd_megakernel, dim3(grid), dim3(512), args, LDS_BYTES, stream);
    if (e != hipSuccess) fprintf(stderr, "kernel_launch: cooperative launch failed: %s (grid %d)\n", hipGetErrorString(e), grid);
}
```

```cpp
#include <hip/hip_runtime.h>
#include <hip/hip_cooperative_groups.h>
#include <cstdio>
#include <cstdint>
#include <cmath>
#include <hip/hip_bf16.h>
namespace cg = cooperative_groups;
#ifndef REP_ATT
#define REP_ATT 1
#endif
#ifndef REP_P4
#define REP_P4 1
#endif
#ifndef REP_P1
#define REP_P1 1
#endif
#ifndef REP_P2B
#define REP_P2B 1
#endif
#ifndef REP_P0
#define REP_P0 1
#endif
#ifndef REP_SYNC
#define REP_SYNC 0
#endif
#ifndef REP_SGU
#define REP_SGU 1
#endif
#ifndef FUSE_SGU
#define FUSE_SGU 1
#endif
#ifndef PH
#define PH 63
#endif
namespace pg8 {
#define PG8_LAS __attribute__((address_space(3)))
typedef unsigned short bf16_t;
typedef short bf16x8 __attribute__((ext_vector_type(8)));
typedef float f32x4 __attribute__((ext_vector_type(4)));
typedef unsigned u32x4 __attribute__((ext_vector_type(4)));
constexpr int BM = 256, BK = 64, HALF = 128, HTB = HALF * BK * 2  , STAGE_BYTES = 8 * HTB, NXCD = 8, WGM = 8;

__host__ __device__ __forceinline__ int lds_byte(int r, int c) { const int st = (r >> 4) * 2 + (c >> 5), rr = r & 15, cc = c & 31, ob = rr * 64 + cc * 2; return st * 1024 + (ob ^ (((ob >> 9) & 1) << 5)); }
__host__ __device__ __forceinline__ void stage_rc(int b, int& R, int& C) { const int st = b / 1024, sb = b % 1024, swz = sb ^ (((sb >> 9) & 1) << 5); R = (st >> 1) * 16 + swz / 64; C = (st & 1) * 32 + (swz % 64) / 2; }
__host__ __device__ __forceinline__ int perm32(int rho) { const int n = rho >> 4, i = rho & 15; return 8 * (i >> 2) + 4 * n + (i & 3); }

struct Unit { int pm, pn, ui; };
struct Gemm { const bf16_t* A; const bf16_t* Bt; int M, N, K; int a_tile_rows, a_half_rows, a_skip; };

struct StaticOrder {
    int nM, nN, nwg, G, c;
    __host__ __device__ void init(int M, int N, int G_, int c_) { nM = M / BM; nN = N / BM; nwg = nM * nN; G = G_; c = c_; }
    __host__ __device__ bool next(int i, Unit& u) const {
        const long L = (long)i * G + c; if (L >= nwg) return false;
        int wgid = (int)L; { const int q = nwg / NXCD, r = nwg % NXCD, xcd = wgid % NXCD, off = wgid / NXCD; wgid = (xcd < r ? xcd * (q + 1) : r * (q + 1) + (xcd - r) * q) + off; }
        const int nig = WGM * nN, gid = wgid / nig, fm = gid * WGM, gsz = (nM - fm) < WGM ? (nM - fm) : WGM;
        u.pm = fm + ((wgid % nig) % gsz); u.pn = (wgid % nig) / gsz; u.ui = i; return true;
    }
    __device__ __forceinline__ void a_ready(const Unit&) const {}
    __device__ __forceinline__ void done(const Unit&) const {}
};

__device__ __forceinline__ unsigned cvt_pk_bf16(float lo, float hi) { unsigned r; asm volatile("v_cvt_pk_bf16_f32 %0, %1, %2" : "=v"(r) : "v"(lo), "v"(hi)); return r; }
template <class Epi, class Sched, bool ALIGN_EPI = false, bool SP2 = false>
__device__ __forceinline__ void gemm_phase(PG8_LAS unsigned char* lds, const Gemm g, const Sched& S, const Epi& E) {
    int tid_ = threadIdx.x; asm volatile("" : "+v"(tid_));
    const int tid = tid_, wid = __builtin_amdgcn_readfirstlane(tid >> 6), lane = tid & 63, wr = wid >> 2, wc = wid & 3, fr = lane & 15, fq = lane >> 4;
    const int K = g.K, nt = K / BK;
    unsigned voffA[2], voffB[2];
#pragma unroll
    for (int i = 0; i < 2; ++i) { int R, C; stage_rc(tid * 16 + i * 8192, R, C); const int Rb = Epi::PERM ? ((R & ~31) + perm32(R & 31)) : R;
        voffA[i] = (unsigned)((R - g.a_skip * (R >> 6)) * K + C) * 2u; voffB[i] = (unsigned)(Rb * K + C) * 2u; }
    const size_t kstep = (size_t)(BK * 2);
    const size_t hstepB = (size_t)HALF * K * 2, hstepA = (size_t)g.a_half_rows * K * 2;
    const size_t tstepB = 2 * hstepB, tstepA = (size_t)g.a_tile_rows * K * 2;
    const unsigned ldsw = (unsigned)wid * 1024u;
    const int aoff = lds_byte(wr * 64 + fr, fq * 8), boff = lds_byte(wc * 32 + fr, fq * 8);
#define PG8_SA(b, h) (((b) * 2 + (h)) * HTB)
#define PG8_SB(b, h) ((4 + (b) * 2 + (h)) * HTB)
#define PG8_STAGE(bufoff, gbase, voff) do { _Pragma("unroll") for (int _i = 0; _i < 2; ++_i) \
        __builtin_amdgcn_global_load_lds((const unsigned*)((const char*)(gbase) + (voff)[_i]), (PG8_LAS unsigned*)(lds + (bufoff) + ldsw + _i * 8192), 16, 0, 0); } while (0)
#define PG8_LDA(dst, b, h) do { _Pragma("unroll") for (int m = 0; m < 4; ++m) _Pragma("unroll") for (int k = 0; k < 2; ++k) dst[m][k] = *(const PG8_LAS bf16x8*)(lds + PG8_SA(b, h) + aoff + m * 2048 + k * 1024); } while (0)
#define PG8_LDB(dst, b, h) do { _Pragma("unroll") for (int n = 0; n < 2; ++n) _Pragma("unroll") for (int k = 0; k < 2; ++k) dst[n][k] = *(const PG8_LAS bf16x8*)(lds + PG8_SB(b, h) + boff + n * 2048 + k * 1024); } while (0)
#define PG8_MMA(ai, bj, At, Bt) do { __builtin_amdgcn_s_setprio(1); _Pragma("unroll") for (int m = 0; m < 4; ++m) _Pragma("unroll") for (int n = 0; n < 2; ++n) _Pragma("unroll") for (int k = 0; k < 2; ++k) \
        acc[ai][bj][m][n] = __builtin_amdgcn_mfma_f32_16x16x32_bf16(Bt[n][k], At[m][k], acc[ai][bj][m][n], 0, 0, 0); __builtin_amdgcn_s_setprio(0); } while (0)
#define PG8_WAIT_V(n) asm volatile("s_waitcnt vmcnt(" #n ")" ::: "memory")
#define PG8_WAIT_L(n) asm volatile("s_waitcnt lgkmcnt(" #n ")" ::: "memory")
#define PG8_BAR __builtin_amdgcn_s_barrier()
#define PG8_SCHED __builtin_amdgcn_sched_barrier(0)
    Unit cur, nxt; int ui = 0;
    if (!S.next(0, cur)) return;
    f32x4 acc[2][2][4][2];
#pragma unroll
    for (int a = 0; a < 2; ++a)
#pragma unroll
        for (int b = 0; b < 2; ++b)
#pragma unroll
            for (int m = 0; m < 4; ++m)
#pragma unroll
                for (int n = 0; n < 2; ++n) acc[a][b][m][n] = (f32x4){0.f, 0.f, 0.f, 0.f};
    bf16x8 At[4][2], B0[2][2], B1[2][2];
    const char* cA = (const char*)g.A + (size_t)cur.pm * tstepA; const char* cB = (const char*)g.Bt + (size_t)cur.pn * tstepB;
    S.a_ready(cur);
    if constexpr (SP2) {
        PG8_STAGE(PG8_SB(0, 0), cB, voffB); PG8_STAGE(PG8_SB(0, 1), cB + hstepB, voffB); PG8_STAGE(PG8_SA(0, 0), cA, voffA); PG8_STAGE(PG8_SA(0, 1), cA + hstepA, voffA);
        if (wr == 1) PG8_BAR;
        PG8_WAIT_V(2); PG8_BAR;
        PG8_STAGE(PG8_SB(1, 0), cB + kstep, voffB); PG8_STAGE(PG8_SA(1, 0), cA + kstep, voffA); PG8_STAGE(PG8_SB(1, 1), cB + hstepB + kstep, voffB);
        PG8_WAIT_V(6); PG8_BAR;
    } else {
        PG8_STAGE(PG8_SB(0, 0), cB, voffB); PG8_STAGE(PG8_SA(0, 0), cA, voffA); PG8_STAGE(PG8_SB(0, 1), cB + hstepB, voffB); PG8_STAGE(PG8_SA(0, 1), cA + hstepA, voffA);
        if (wr == 1) PG8_BAR;
        PG8_WAIT_V(4); PG8_BAR;
        PG8_STAGE(PG8_SB(1, 0), cB + kstep, voffB); PG8_STAGE(PG8_SA(1, 0), cA + kstep, voffA); PG8_STAGE(PG8_SB(1, 1), cB + hstepB + kstep, voffB);
        PG8_WAIT_V(6); PG8_BAR;
    }
    for (;;) {
        const bool has_next = S.next(ui + 1, nxt);
        const char* nA = has_next ? (const char*)g.A + (size_t)nxt.pm * tstepA : cA; const char* nB = has_next ? (const char*)g.Bt + (size_t)nxt.pn * tstepB : cB;
        for (int t = 0; t < nt; t += 2) {
            const bool last = (t == nt - 2);
            const char* a1 = cA + (size_t)(t + 1) * kstep;
            const char* a2 = last ? nA : cA + (size_t)(t + 2) * kstep; const char* b2 = last ? nB : cB + (size_t)(t + 2) * kstep;
            const char* a3 = a2 + kstep; const char* b3 = b2 + kstep;
            if (last && has_next) S.a_ready(nxt);
            if constexpr (SP2) {
            PG8_LDB(B0, 0, 0); PG8_LDB(B1, 0, 1); PG8_SCHED; PG8_LDA(At, 0, 0); PG8_STAGE(PG8_SA(1, 1), a1 + hstepA, voffA);
            PG8_WAIT_V(8); PG8_WAIT_L(0); PG8_BAR; PG8_MMA(0, 0, At, B0); PG8_MMA(0, 1, At, B1); PG8_BAR; PG8_SCHED;
            PG8_LDA(At, 0, 1); PG8_STAGE(PG8_SB(0, 0), b2, voffB); PG8_STAGE(PG8_SB(0, 1), b2 + hstepB, voffB); PG8_STAGE(PG8_SA(0, 0), a2, voffA);
            PG8_WAIT_V(8); PG8_WAIT_L(0); PG8_BAR; PG8_MMA(1, 0, At, B0); PG8_MMA(1, 1, At, B1); PG8_BAR; PG8_SCHED;
            PG8_LDB(B0, 1, 0); PG8_LDB(B1, 1, 1); PG8_SCHED; PG8_LDA(At, 1, 0); PG8_STAGE(PG8_SA(0, 1), a2 + hstepA, voffA);
            PG8_WAIT_V(8); PG8_WAIT_L(0); PG8_BAR; PG8_MMA(0, 0, At, B0); PG8_MMA(0, 1, At, B1); PG8_BAR; PG8_SCHED;
            PG8_LDA(At, 1, 1); PG8_STAGE(PG8_SB(1, 0), b3, voffB); PG8_STAGE(PG8_SB(1, 1), b3 + hstepB, voffB); PG8_STAGE(PG8_SA(1, 0), a3, voffA);
            PG8_WAIT_V(8); PG8_WAIT_L(0); PG8_BAR; PG8_MMA(1, 0, At, B0); PG8_MMA(1, 1, At, B1); PG8_BAR; PG8_SCHED;
            } else {
            PG8_LDB(B0, 0, 0); PG8_SCHED; PG8_LDA(At, 0, 0); PG8_STAGE(PG8_SA(1, 1), a1 + hstepA, voffA);
            PG8_WAIT_L(8); PG8_BAR; PG8_WAIT_L(0); PG8_MMA(0, 0, At, B0); PG8_BAR; PG8_SCHED;
            PG8_LDB(B1, 0, 1); PG8_STAGE(PG8_SB(0, 0), b2, voffB);
            PG8_BAR; PG8_WAIT_L(0); PG8_MMA(0, 1, At, B1); PG8_BAR;
            PG8_LDA(At, 0, 1); PG8_STAGE(PG8_SA(0, 0), a2, voffA);
            PG8_BAR; PG8_WAIT_L(0); PG8_MMA(1, 0, At, B0); PG8_BAR; PG8_SCHED;
            PG8_STAGE(PG8_SB(0, 1), b2 + hstepB, voffB);
            PG8_WAIT_V(6); PG8_BAR; PG8_MMA(1, 1, At, B1); PG8_BAR;
            PG8_LDB(B0, 1, 0); PG8_SCHED; PG8_LDA(At, 1, 0); PG8_STAGE(PG8_SA(0, 1), a2 + hstepA, voffA);
            PG8_WAIT_L(8); PG8_BAR; PG8_WAIT_L(0); PG8_MMA(0, 0, At, B0); PG8_BAR; PG8_SCHED;
            PG8_LDB(B1, 1, 1); PG8_STAGE(PG8_SB(1, 0), b3, voffB);
            PG8_BAR; PG8_WAIT_L(0); PG8_MMA(0, 1, At, B1); PG8_BAR;
            PG8_LDA(At, 1, 1); PG8_STAGE(PG8_SA(1, 0), a3, voffA);
            PG8_BAR; PG8_WAIT_L(0); PG8_MMA(1, 0, At, B0); PG8_BAR; PG8_SCHED;
            PG8_STAGE(PG8_SB(1, 1), b3 + hstepB, voffB);
            PG8_WAIT_V(6); PG8_BAR; PG8_MMA(1, 1, At, B1); PG8_BAR;
            }
        }
        if constexpr (ALIGN_EPI) { if (wr == 0) PG8_BAR; }
        if constexpr (!Epi::AFTER_DRAIN) { E(acc, cur, wr, wc, fr, fq); S.done(cur); }
        if (!has_next) break;
#pragma unroll
        for (int a = 0; a < 2; ++a)
#pragma unroll
            for (int b = 0; b < 2; ++b)
#pragma unroll
                for (int m = 0; m < 4; ++m)
#pragma unroll
                    for (int n = 0; n < 2; ++n) acc[a][b][m][n] = (f32x4){0.f, 0.f, 0.f, 0.f};
        cur = nxt; cA = nA; cB = nB; ++ui;
        if constexpr (ALIGN_EPI) { if (wr == 1) PG8_BAR; }
    }
    PG8_WAIT_V(0);
    if constexpr (!ALIGN_EPI) { if (wr == 0) PG8_BAR; }
    PG8_BAR;
    if constexpr (Epi::AFTER_DRAIN) { E.fused(acc, cur, wr, wc, fr, fq, lds, wid, lane); S.done(cur); }
#undef PG8_SA
#undef PG8_SB
#undef PG8_STAGE
#undef PG8_LDA
#undef PG8_LDB
#undef PG8_MMA
#undef PG8_WAIT_V
#undef PG8_WAIT_L
#undef PG8_BAR
#undef PG8_SCHED
}
}
using pg8::bf16_t; using pg8::bf16x8; using pg8::f32x4; using pg8::u32x4;
#define LAS __attribute__((address_space(3)))
typedef float f32x16 __attribute__((ext_vector_type(16)));
typedef float f32x2 __attribute__((ext_vector_type(2)));
typedef unsigned u32x2 __attribute__((ext_vector_type(2)));
typedef short s16x4 __attribute__((ext_vector_type(4)));

constexpr int SEQ = 8192, NB = 2, M = NB * SEQ, D = 1024, DIN = 2560, DFF = 2816, NUP = 2 * DFF, DEPTH = 2;
constexpr int NH = 4, HD = 64, VD = 128;
constexpr float NORM_EPS = 1e-6f, SUBLN_EPS = 1e-5f, LN_EPS = 1e-5f;
constexpr float LOG2E = 1.4426950408889634f;
constexpr float QSCALE = 0.125f * LOG2E;
constexpr int P4_ROWS = 248, P4_TILES = (M + P4_ROWS - 1) / P4_ROWS;

constexpr size_t MiB = 1u << 20;
constexpr size_t WS_SS = 0;
constexpr size_t WS_W = 1 * MiB;
constexpr size_t W_IN = 0, W_OUT = 5 * MiB, W_UP = 7 * MiB, W_DOWN = 18 * MiB, W_LAYER = 47 * MiB / 2;
constexpr size_t WS_XB = 48 * MiB;
constexpr size_t WS_Z = 80 * MiB;
constexpr size_t WS_MIX = 160 * MiB;
constexpr size_t WS_Y = 80 * MiB;
constexpr size_t WS_OP1 = 192 * MiB;
constexpr size_t WS_CTL = 224 * MiB, CTL_BYTES = 131072;
constexpr size_t WS_END = 225 * MiB;
static_assert(WS_W + 2 * W_LAYER <= WS_XB && WS_Y + (size_t)M * DFF * 2 <= WS_OP1 && WS_MIX + (size_t)M * D * 2 <= WS_OP1, "ws map");

constexpr int RING_BYTES = 131072, LDS_BYTES = 147456;

__device__ __forceinline__ unsigned f2bf(float f) { unsigned u = __builtin_bit_cast(unsigned, f); return (u + 0x7fffu + ((u >> 16) & 1u)) >> 16; }
__device__ __forceinline__ unsigned pk2(float lo, float hi) { return f2bf(lo) | (f2bf(hi) << 16); }
__device__ __forceinline__ unsigned cvtpk(float lo, float hi) { return pg8::cvt_pk_bf16(lo, hi); }
__device__ __forceinline__ float bf2f(unsigned short b) { return __builtin_bit_cast(float, (unsigned)b << 16); }
__device__ __forceinline__ float bflo(unsigned w) { return __builtin_bit_cast(float, w << 16); }
__device__ __forceinline__ float bfhi(unsigned w) { return __builtin_bit_cast(float, w & 0xffff0000u); }
__device__ __forceinline__ float shx(float v, int mask, int lane) { return __builtin_bit_cast(float, __builtin_amdgcn_ds_bpermute((lane ^ mask) << 2, __builtin_bit_cast(int, v))); }
__device__ __forceinline__ float wave_sum(float v, int lane) {
#pragma unroll
    for (int o = 1; o < 64; o <<= 1) v += shx(v, o, lane);
    return v;
}
__device__ __forceinline__ float gelu_t(float x) {
    const float u = x * (1.0f + 0.044715f * x * x);
    const float e = __builtin_amdgcn_exp2f(-2.302208198f * u);
    return x * __builtin_amdgcn_rcpf(1.0f + e);
}
__device__ __forceinline__ f32x2 gelu_t2(f32x2 x) {
    f32x2 t = x * x; t = t * 0.044715f + 1.0f; const f32x2 u = (x * t) * (-2.302208198f);
    f32x2 e; e.x = __builtin_amdgcn_exp2f(u.x); e.y = __builtin_amdgcn_exp2f(u.y); e = e + 1.0f;
    f32x2 r; r.x = __builtin_amdgcn_rcpf(e.x); r.y = __builtin_amdgcn_rcpf(e.y);
    return x * r;
}
__device__ __forceinline__ float row_rstd(const float* ss, int row, float eps) {
    const f32x4* p = (const f32x4*)(ss + (size_t)row * 16);
    const f32x4 a = p[0], b = p[1], c = p[2], d = p[3];
    const float s = (((a[0] + a[1]) + (a[2] + a[3])) + ((b[0] + b[1]) + (b[2] + b[3]))) + (((c[0] + c[1]) + (c[2] + c[3])) + ((d[0] + d[1]) + (d[2] + d[3])));
    return __builtin_amdgcn_rsqf(s * (1.0f / D) + eps);
}
constexpr int RSTAB_OFF = RING_BYTES;
template <bool P4MAP, class Sched> __device__ __forceinline__ void fill_rstd(LAS unsigned char* lds, const Sched& S, const float* ss) {
    int t = threadIdx.x; asm volatile("" : "+v"(t));
    LAS float* tab = (LAS float*)(lds + RSTAB_OFF); pg8::Unit u;
    const int r = t & 255, h = t >> 8;
#pragma unroll
    for (int k = 0; k < 4; ++k) { const int i = 2 * k + h;
        if (S.next(i, u)) {
            int tok = P4MAP ? u.pm * P4_ROWS + 62 * (r >> 6) + (r & 63) - 2 : u.pm * 256 + r; tok = tok < 0 ? 0 : (tok > M - 1 ? M - 1 : tok);
            tab[i * 256 + r] = row_rstd(ss, tok, NORM_EPS); } }
    __syncthreads();
}

struct EpiInProj {
    static constexpr bool PERM = true, AFTER_DRAIN = false;
    bf16_t* Z; LAS const float* tab; bool wt;
    __device__ __forceinline__ void operator()(f32x4 (&acc)[2][2][4][2], const pg8::Unit& u, int wr, int wc, int fr, int fq) const {
        asm volatile("" : "+v"(fr), "+v"(fq));
        const __amdgpu_buffer_rsrc_t zr = __builtin_amdgcn_make_buffer_rsrc((void*)Z, 0, M * DIN * 2, 0x00020000);
        const int row0 = u.pm * 256 + wr * 64 + fr, col0 = u.pn * 256 + wc * 32 + 8 * fq;
#pragma unroll
        for (int ai = 0; ai < 2; ++ai)
#pragma unroll
            for (int m = 0; m < 4; ++m) {
                const int row = row0 + ai * 128 + m * 16; const float rs = tab[u.ui * 256 + ai * 128 + wr * 64 + m * 16 + fr];
                bf16_t* rowp = Z + (size_t)row * DIN + col0;
#pragma unroll
                for (int bj = 0; bj < 2; ++bj) { const f32x4 v0 = acc[ai][bj][m][0] * rs, v1 = acc[ai][bj][m][1] * rs;
                    u32x4 w; w.x = cvtpk(v0[0], v0[1]); w.y = cvtpk(v0[2], v0[3]); w.z = cvtpk(v1[0], v1[1]); w.w = cvtpk(v1[2], v1[3]);
                    if (wt && u.ui == 0) __builtin_amdgcn_raw_buffer_store_b128(w, zr, (unsigned)(((size_t)row * DIN + col0 + bj * 128) * 2), 0,   16);
                    else *(u32x4*)(rowp + bj * 128) = w; }
            }
    }
};
struct InProjOrder {
    pg8::StaticOrder A, B; unsigned* cnt; bool pub;
    __device__ void init(int G_, int c_, unsigned* cnt_, bool pub_) { A.init(M, 1024, G_, c_); B.init(M, 1536, G_, c_); cnt = cnt_; pub = pub_; }
    __device__ bool next(int i, pg8::Unit& u) const { if (i == 0) { const bool ok = A.next(0, u); u.pn += 6; u.ui = 0; return ok; } const bool ok = B.next(i - 1, u); u.ui = i; return ok; }
    __device__ __forceinline__ void a_ready(const pg8::Unit&) const {}
    __device__ __forceinline__ void done(const pg8::Unit& u) const {
        if (pub && u.ui == 0) { asm volatile("s_waitcnt vmcnt(0)" ::: "memory"); __builtin_amdgcn_s_barrier(); asm volatile("" ::: "memory");
            if (threadIdx.x == 0) __hip_atomic_fetch_add(cnt, 1u, __ATOMIC_RELAXED, __HIP_MEMORY_SCOPE_AGENT); }
    }
};
struct EpiRes {
    static constexpr bool PERM = true, AFTER_DRAIN = false;
    const float* resf; bf16_t* xb; float* ss;
    __device__ __forceinline__ void operator()(f32x4 (&acc)[2][2][4][2], const pg8::Unit& u, int wr, int wc, int fr, int fq) const {
        asm volatile("" : "+v"(fr), "+v"(fq));
        const int col0 = u.pn * 256 + wc * 32 + 8 * fq;
#pragma unroll
        for (int ai = 0; ai < 2; ++ai)
#pragma unroll
            for (int m = 0; m < 4; ++m) {
                const int row = u.pm * 256 + ai * 128 + wr * 64 + m * 16 + fr; float sq = 0.f;
#pragma unroll
                for (int bj = 0; bj < 2; ++bj) { const size_t off = (size_t)row * D + col0 + bj * 128;
                    f32x4 r0, r1;
                    if (resf) { r0 = *(const f32x4*)(resf + off); r1 = *(const f32x4*)(resf + off + 4); }
                    else { const u32x4 w = *(const u32x4*)(xb + off); r0 = (f32x4){bflo(w.x), bfhi(w.x), bflo(w.y), bfhi(w.y)}; r1 = (f32x4){bflo(w.z), bfhi(w.z), bflo(w.w), bfhi(w.w)}; }
                    const f32x4 o0 = r0 + acc[ai][bj][m][0], o1 = r1 + acc[ai][bj][m][1];
                    sq += ((o0[0] * o0[0] + o0[1] * o0[1]) + (o0[2] * o0[2] + o0[3] * o0[3])) + ((o1[0] * o1[0] + o1[1] * o1[1]) + (o1[2] * o1[2] + o1[3] * o1[3]));
                    u32x4 w; w.x = cvtpk(o0[0], o0[1]); w.y = cvtpk(o0[2], o0[3]); w.z = cvtpk(o1[0], o1[1]); w.w = cvtpk(o1[2], o1[3]);
                    *(u32x4*)(xb + off) = w; }
                { const int ln_ = fq * 16 + fr; sq += shx(sq, 16, ln_); sq += shx(sq, 32, ln_); }
                if (fq == 0) ss[(size_t)row * 16 + u.pn * 4 + wc] = sq;
            }
    }
};
struct EpiResFinal {
    static constexpr bool PERM = true, AFTER_DRAIN = false;
    const bf16_t* xb; float* ss; float* out; const float* fg; unsigned* cnt; LAS float* tab;
    __device__ __forceinline__ void operator()(f32x4 (&acc)[2][2][4][2], const pg8::Unit& u, int wr, int wc, int fr, int fq) const {
        asm volatile("" : "+v"(fr), "+v"(fq));
        const int col0 = u.pn * 256 + wc * 32 + 8 * fq;
#pragma unroll
        for (int ai = 0; ai < 2; ++ai)
#pragma unroll
            for (int m = 0; m < 4; ++m) {
                const int row = u.pm * 256 + ai * 128 + wr * 64 + m * 16 + fr; float sq = 0.f;
#pragma unroll
                for (int bj = 0; bj < 2; ++bj) { const size_t off = (size_t)row * D + col0 + bj * 128;
                    const u32x4 w = *(const u32x4*)(xb + off);
                    const f32x4 o0 = (f32x4){bflo(w.x), bfhi(w.x), bflo(w.y), bfhi(w.y)} + acc[ai][bj][m][0], o1 = (f32x4){bflo(w.z), bfhi(w.z), bflo(w.w), bfhi(w.w)} + acc[ai][bj][m][1];
                    sq += ((o0[0] * o0[0] + o0[1] * o0[1]) + (o0[2] * o0[2] + o0[3] * o0[3])) + ((o1[0] * o1[0] + o1[1] * o1[1]) + (o1[2] * o1[2] + o1[3] * o1[3]));
                    acc[ai][bj][m][0] = o0; acc[ai][bj][m][1] = o1; }
                { const int ln_ = fq * 16 + fr; sq += shx(sq, 16, ln_); sq += shx(sq, 32, ln_); }
                if (fq == 0) __hip_atomic_store(ss + (size_t)row * 16 + u.pn * 4 + wc, sq, __ATOMIC_RELAXED, __HIP_MEMORY_SCOPE_AGENT);
            }
        asm volatile("s_waitcnt vmcnt(0)" ::: "memory"); __builtin_amdgcn_s_barrier(); asm volatile("" ::: "memory");
        int t = threadIdx.x; asm volatile("" : "+v"(t));
        if (t == 0) { unsigned* c = cnt + 64 * u.pm; __hip_atomic_fetch_add(c, 1u, __ATOMIC_RELAXED, __HIP_MEMORY_SCOPE_AGENT);
            unsigned sp = 0; while (__hip_atomic_load(c, __ATOMIC_RELAXED, __HIP_MEMORY_SCOPE_AGENT) < 4u) { __builtin_amdgcn_s_sleep(1); if (++sp > (1u << 22)) break; }
            __builtin_amdgcn_fence(__ATOMIC_ACQUIRE, "agent"); asm volatile("s_waitcnt vmcnt(0)" ::: "memory"); }
        __builtin_amdgcn_s_barrier(); asm volatile("" ::: "memory");
        if (t < 256) tab[t] = row_rstd(ss, u.pm * 256 + t, NORM_EPS);
        asm volatile("s_waitcnt lgkmcnt(0)" ::: "memory"); __builtin_amdgcn_s_barrier(); asm volatile("" ::: "memory");
        f32x4 g0[2], g1[2];
#pragma unroll
        for (int bj = 0; bj < 2; ++bj) { g0[bj] = *(const f32x4*)(fg + col0 + bj * 128); g1[bj] = *(const f32x4*)(fg + col0 + bj * 128 + 4); }
#pragma unroll
        for (int ai = 0; ai < 2; ++ai)
#pragma unroll
            for (int m = 0; m < 4; ++m) {
                const int lr = ai * 128 + wr * 64 + m * 16 + fr; const float rs = tab[lr]; float* op = out + (size_t)(u.pm * 256 + lr) * D + col0;
#pragma unroll
                for (int bj = 0; bj < 2; ++bj) { __builtin_nontemporal_store(acc[ai][bj][m][0] * rs * g0[bj], (f32x4*)(op + bj * 128)); __builtin_nontemporal_store(acc[ai][bj][m][1] * rs * g1[bj], (f32x4*)(op + bj * 128 + 4)); }
            }
    }
};
template <int CTRL> __device__ __forceinline__ float dppf(float old, float src) {
    return __builtin_bit_cast(float, __builtin_amdgcn_update_dpp(__builtin_bit_cast(int, old), __builtin_bit_cast(int, src), CTRL, 0xf, 0xf, false)); }
template <int CTRL> __device__ __forceinline__ float dppz(float src) {
    return __builtin_bit_cast(float, __builtin_amdgcn_mov_dpp(__builtin_bit_cast(int, src), CTRL, 0xf, 0xf, true)); }
struct EpiConvGate {
    static constexpr bool PERM = true, AFTER_DRAIN = false;
    bf16_t* Y; LAS const float* tab; const float* cw; const float* cb;
    template <bool MASK> __device__ __forceinline__ void run(f32x4 (&acc)[2][2][4][2], const pg8::Unit& u, int wr, int wc, int fr, int fq) const {
        const int ch0 = u.pn * 128 + wc * 32 + 8 * fq;
        u32x2 park[2][4];
#pragma unroll
        for (int n = 0; n < 2; ++n) {
            asm volatile("" ::: "memory");
            const int ch = ch0 + 4 * n;
            f32x4 w0[2], w1[2], w2[2], bb[2];
#pragma unroll
            for (int bj = 0; bj < 2; ++bj) { const int col = bj * DFF + ch;
                w0[bj] = *(const f32x4*)(cw + col); w1[bj] = *(const f32x4*)(cw + NUP + col); w2[bj] = *(const f32x4*)(cw + 2 * NUP + col); bb[bj] = *(const f32x4*)(cb + col); }
#pragma unroll
            for (int ai = 0; ai < 2; ++ai)
#pragma unroll
                for (int m = 0; m < 4; ++m) {
                    const int tok = u.pm * P4_ROWS + 62 * (2 * ai + wr) + 16 * m + fr - 2; const int tpos = tok & (SEQ - 1);
                    f32x4 o[2];
#pragma unroll
                    for (int bj = 0; bj < 2; ++bj) {
                        const f32x4 cur = acc[ai][bj][m][n]; const f32x4 prv = acc[ai][bj][m > 0 ? m - 1 : 0][n];
                        f32x4 p1, p2;
#pragma unroll
                        for (int i = 0; i < 4; ++i) {
                            p1[i] = dppf<0x111>(dppz<0x10f>(prv[i]), cur[i]);
                            p2[i] = dppf<0x112>(dppz<0x10e>(prv[i]), cur[i]);
                            if (MASK) { p1[i] = tpos >= 1 ? p1[i] : 0.f; p2[i] = tpos >= 2 ? p2[i] : 0.f; }
                        }
                        o[bj] = bb[bj] + w2[bj] * cur + w1[bj] * p1 + w0[bj] * p2;
                    }
                    const f32x2 ga = gelu_t2((f32x2){o[0][0], o[0][1]}) * (f32x2){o[1][0], o[1][1]}, gb = gelu_t2((f32x2){o[0][2], o[0][3]}) * (f32x2){o[1][2], o[1][3]};
                    u32x2 w; w.x = cvtpk(ga.x, ga.y); w.y = cvtpk(gb.x, gb.y);
                    if (n == 0) park[ai][m] = w;
                    else if ((m > 0 || fr >= 2) && tok < M) { u32x4 w4; w4.x = park[ai][m].x; w4.y = park[ai][m].y; w4.z = w.x; w4.w = w.y; *(u32x4*)(Y + (size_t)tok * DFF + ch0) = w4; }
                }
        }
    }
    __device__ __forceinline__ void operator()(f32x4 (&acc)[2][2][4][2], const pg8::Unit& u, int wr, int wc, int fr, int fq) const {
        asm volatile("" : "+v"(fr), "+v"(fq));
#pragma unroll
        for (int ai = 0; ai < 2; ++ai)
#pragma unroll
            for (int m = 0; m < 4; ++m) {
                const float rs = tab[u.ui * 256 + ai * 128 + wr * 64 + m * 16 + fr];
#pragma unroll
                for (int bj = 0; bj < 2; ++bj)
#pragma unroll
                    for (int n = 0; n < 2; ++n) acc[ai][bj][m][n] *= rs;
            }
        const int t0 = u.pm * P4_ROWS - 2;
        if (((t0 + 255) >> 13) != ((t0 - 2) >> 13)) run<true>(acc, u, wr, wc, fr, fq); else run<false>(acc, u, wr, wc, fr, fq);
    }
};
namespace attn_body {
using bf16=__hip_bfloat16;
using bf16x8=__attribute__((ext_vector_type(8)))short;
using s16x4=__attribute__((ext_vector_type(4)))short;
using f32x16=__attribute__((ext_vector_type(16)))float;
using u32x4=__attribute__((ext_vector_type(4)))unsigned;
constexpr int SEQ=8192,D=64,ZP=2560,OP=512;
constexpr int NW=8,QBLK=32,QB=QBLK*NW,KVBLK=64,NQB=SEQ/QB;
constexpr int ATTN_UNIT_ROWS=QB;
__device__ __forceinline__ int crow(int r,int hi){return (r&3)+8*(r>>2)+4*hi;}
#define SBAR() __builtin_amdgcn_sched_barrier(0)
__device__ __forceinline__ void cmask(f32x16&p0,f32x16&p1,int jb,int qrel,int hi){
  const float NEG=-INFINITY; int kb=64*jb+4*hi;
  #pragma unroll
  for(int r=0;r<16;++r){int kv=kb+(r&3)+8*(r>>2); if(kv>qrel)p0[r]=NEG; if(kv+32>qrel)p1[r]=NEG;}
}

constexpr int NSLOT=3, SLOTB=8192;
constexpr int LDS_K=0, LDS_V=NSLOT*SLOTB, LDS_WS=LDS_V+NSLOT*2*SLOTB, LDS_OST=LDS_WS+NW*64*4, LDS_BYTES=LDS_OST+NW*8192;
constexpr float C2=0.125f*1.4426950408889634f;
__device__ __forceinline__ void glds16(const void*gsrc,unsigned lds_dst){unsigned keep;
  asm volatile("s_mov_b32 %0, m0\n\ts_mov_b32 m0, %2\n\ts_nop 0\n\tglobal_load_lds_dwordx4 %1, off\n\ts_mov_b32 m0, %0":"=&s"(keep):"v"(gsrc),"s"(lds_dst):"memory");}
__device__ __forceinline__ float max3f(float a,float b,float c){float r;asm("v_max3_f32 %0, %1, %2, %3":"=v"(r):"v"(a),"v"(b),"v"(c));return r;}
__device__ __forceinline__ float max2f(float a,float b){float r;asm("v_max_f32_e32 %0, %1, %2":"=v"(r):"v"(a),"v"(b));return r;}
__device__ __forceinline__ float fadd_s(float a,float b){float r;asm("v_add_f32_e32 %0, %1, %2":"=v"(r):"v"(a),"v"(b));return r;}
__device__ __forceinline__ float fsub_s(float a,float b){float r;asm("v_sub_f32_e32 %0, %1, %2":"=v"(r):"v"(a),"v"(b));return r;}
typedef float f32x2_t __attribute__((ext_vector_type(2))); typedef float f32x4_t __attribute__((ext_vector_type(4))); typedef __bf16 bf16x2_t __attribute__((ext_vector_type(2)));
__device__ __forceinline__ unsigned cvtpk_s(float lo,float hi){f32x2_t v={lo,hi};bf16x2_t b=__builtin_convertvector(v,bf16x2_t);return __builtin_bit_cast(unsigned,b);}
__device__ __forceinline__ float bfr(float x){unsigned u=__float_as_uint(x);u=(u+0x7fffu+((u>>16)&1u))&0xffff0000u;return __uint_as_float(u);}
#define WAIT_BAR(N) asm volatile("s_waitcnt vmcnt(" #N ") lgkmcnt(0)\n\ts_barrier":::"memory")

__device__ __forceinline__ void qkt(f32x16&p0,f32x16&p1,const char*Kslot,const bf16x8*qr,const f32x16&c0,const f32x16&c1,int r32,int hi){
  const char*kb=Kslot+hi*1024+r32*16;
  #pragma unroll
  for(int d0=0;d0<4;++d0){
    const bf16x8 b0=*reinterpret_cast<const bf16x8*>(kb+d0*2048);
    const bf16x8 b1=*reinterpret_cast<const bf16x8*>(kb+d0*2048+512);
    if(d0==0){p0=__builtin_amdgcn_mfma_f32_32x32x16_bf16(b0,qr[0],c0,0,0,0);p1=__builtin_amdgcn_mfma_f32_32x32x16_bf16(b1,qr[0],c1,0,0,0);}
    else{p0=__builtin_amdgcn_mfma_f32_32x32x16_bf16(b0,qr[d0],p0,0,0,0);p1=__builtin_amdgcn_mfma_f32_32x32x16_bf16(b1,qr[d0],p1,0,0,0);}}
}
typedef __attribute__((address_space(3))) const char* lds_cptr;
typedef short v4i16_t __attribute__((ext_vector_type(4)));
__device__ __forceinline__ void kload8(bf16x8*kf,lds_cptr kp){
  kf[0]=*(const __attribute__((address_space(3))) bf16x8*)(kp);      kf[1]=*(const __attribute__((address_space(3))) bf16x8*)(kp+512);
  kf[2]=*(const __attribute__((address_space(3))) bf16x8*)(kp+2048); kf[3]=*(const __attribute__((address_space(3))) bf16x8*)(kp+2560);
  kf[4]=*(const __attribute__((address_space(3))) bf16x8*)(kp+4096); kf[5]=*(const __attribute__((address_space(3))) bf16x8*)(kp+4608);
  kf[6]=*(const __attribute__((address_space(3))) bf16x8*)(kp+6144); kf[7]=*(const __attribute__((address_space(3))) bf16x8*)(kp+6656);
}
__device__ __forceinline__ void kload2(bf16x8*kf,lds_cptr kp,int j){ kf[2*j]=*(const __attribute__((address_space(3))) bf16x8*)(kp+j*2048); kf[2*j+1]=*(const __attribute__((address_space(3))) bf16x8*)(kp+j*2048+512); }
__device__ __forceinline__ s16x4 vtr(lds_cptr p){ return __builtin_bit_cast(s16x4,__builtin_amdgcn_ds_read_tr16_b64_v4i16((__attribute__((address_space(3))) v4i16_t*)p)); }
__device__ __forceinline__ float rowmax(const f32x16&p0,const f32x16&p1){
  float a=max3f(p0[0],p0[1],p1[0]),b=max3f(p0[2],p0[3],p1[1]);a=max3f(a,p1[2],p1[3]);
  #pragma unroll
  for(int r=4;r<16;r+=4){a=max3f(a,p0[r],p0[r+1]);b=max3f(b,p0[r+2],p0[r+3]);a=max3f(a,p1[r],p1[r+1]);b=max3f(b,p1[r+2],p1[r+3]);}
  const float m=max2f(a,b);
  auto rr=__builtin_amdgcn_permlane32_swap(__float_as_uint(m),__float_as_uint(m),false,false);
  return max2f(__uint_as_float(rr[0]),__uint_as_float(rr[1]));
}
__device__ __forceinline__ void pv(f32x16*o,int vb,bf16x8 pa0,bf16x8 pa1,bf16x8 pa2,bf16x8 pa3){
  #pragma unroll
  for(int d0=0;d0<4;++d0){s16x4 lo[4],hi[4];
    #pragma unroll
    for(int ks=0;ks<4;++ks){
      asm volatile("ds_read_b64_tr_b16 %0,%1 offset:%c2":"=&v"(lo[ks]):"v"(vb),"i"(d0*4096+ks*1024):"memory");
      asm volatile("ds_read_b64_tr_b16 %0,%1 offset:%c2":"=&v"(hi[ks]):"v"(vb),"i"(d0*4096+ks*1024+512):"memory");}
    asm volatile("s_waitcnt lgkmcnt(0)":::"memory");SBAR();
    #define PK(k) (bf16x8){lo[k][0],lo[k][1],lo[k][2],lo[k][3],hi[k][0],hi[k][1],hi[k][2],hi[k][3]}
    o[d0]=__builtin_amdgcn_mfma_f32_32x32x16_bf16(pa0,PK(0),o[d0],0,0,0);
    o[d0]=__builtin_amdgcn_mfma_f32_32x32x16_bf16(pa1,PK(1),o[d0],0,0,0);
    o[d0]=__builtin_amdgcn_mfma_f32_32x32x16_bf16(pa2,PK(2),o[d0],0,0,0);
    o[d0]=__builtin_amdgcn_mfma_f32_32x32x16_bf16(pa3,PK(3),o[d0],0,0,0);
    #undef PK
  }
}

#ifndef ATTN_STORE16
#define ATTN_STORE16(p,v) (*(u32x4*)(p)=(v))
#endif
template<int THRL> __device__ __forceinline__ void attn_unit(int b,int qb,const bf16*Q,const bf16*__restrict__ K,const bf16*__restrict__ V,bf16*O,char*shm,float slope2,const int F_fmode,unsigned*F_flag,unsigned short*F_mixo,const float F_lam,const float F_gscale,const float*F_sg){
  int tid_=threadIdx.x; asm volatile("":"+v"(tid_));
  const int tid=tid_,lane=tid&63,r32=lane&31,hi=lane>>5; const int wid=__builtin_amdgcn_readfirstlane(tid>>6);
  const long rowbase=(long)b*SEQ; const int q0=qb*QB;
  const bf16*Qw=Q+(rowbase+q0+wid*QBLK)*ZP;
  const bf16*Kh=K+rowbase*ZP,*Vh=V+rowbase*ZP;
  const unsigned lds0=(unsigned)(uintptr_t)shm;
  float*wsf=(float*)(shm+LDS_WS)+wid*64;
  const bf16*ksrc=Kh+(long)lane*ZP+wid*8;
  const bf16*vsrc=Vh+(long)(16*(wid&3)+(lane>>2))*ZP+(wid>>2)*32+(lane&3)*8;
  const unsigned kdst=lds0+LDS_K+wid*1024, vdst=lds0+LDS_V+wid*1024;
  #define DMA_K(t,slot) glds16(ksrc+(long)(t)*KVBLK*ZP,(unsigned)__builtin_amdgcn_readfirstlane(kdst+(slot)))
  #define DMA_V(t,slot) do{ glds16(vsrc+(long)(t)*KVBLK*ZP,(unsigned)__builtin_amdgcn_readfirstlane(vdst+2*(slot))); glds16(vsrc+64+(long)(t)*KVBLK*ZP,(unsigned)__builtin_amdgcn_readfirstlane(vdst+8192+2*(slot))); }while(0)
  const int vb0=(int)(lds0+LDS_V)+((lane>>4)&1)*32+(lane&3)*8+(4*hi+((lane&15)>>2))*64;
  const char*Kbase=shm+LDS_K; bf16x8 kf[8];
  const lds_cptr shm3=(lds_cptr)shm; const lds_cptr kp0=shm3+LDS_K+hi*1024+r32*16; const lds_cptr vp0=shm3+LDS_V+((lane>>4)&1)*32+(lane&3)*8+(4*hi+((lane&15)>>2))*64;
  const int NT=(q0+QB)/KVBLK;
  bf16x8 qbf; unsigned locA,locB; constexpr unsigned kbA0=0u,kbB0=0u;
  { float sl_=slope2; asm volatile("":"+v"(sl_));
    const float a1=bfr(sl_), r1=sl_-a1, a2=bfr(r1), a3=bfr(r1-a2);
    const unsigned A1=__float_as_uint(a1)>>16,A2=__float_as_uint(a2)>>16,A3=__float_as_uint(a3)>>16,B1=__float_as_uint(64.f*a1)>>16,B2=__float_as_uint(64.f*a2)>>16,B3=__float_as_uint(64.f*a3)>>16;
    const u32x4 w=hi?(u32x4){0u,0u,0u,0u}:(u32x4){A1|(A2<<16),A3|(B1<<16),B2|(B3<<16),0u}; qbf=__builtin_bit_cast(bf16x8,w);
    locA=hi?0u:(__float_as_uint((float)r32)>>16); locB=hi?0u:(__float_as_uint((float)(r32+32))>>16); }
  const unsigned one2=hi?0u:0x3f803f80u;
  #define SETM() do{ const float mh_=bfr(mhat), ml_=mhat-mh_; u32x4 w_=__builtin_bit_cast(u32x4,qbf); w_.w=hi?0u:((__float_as_uint(-mh_)>>16)|(__float_as_uint(-ml_)&0xffff0000u)); qbf=__builtin_bit_cast(bf16x8,w_); }while(0)
  #define TRB(t) (hi?0u:(__float_as_uint((float)((t)-(NT-4)))>>16))
  #define KBIAS(t,W0,LOC,TB) ({ unsigned l_=(LOC); asm volatile("":"+v"(l_)); __builtin_bit_cast(bf16x8,(u32x4){l_|(l_<<16),l_|((TB)<<16),(TB)|((TB)<<16),one2}); })
  #define BIASC(t,W0,LOC,TB) __builtin_amdgcn_mfma_f32_32x32x16_bf16(KBIAS(t,W0,LOC,TB),qbf,f32x16{},0,0,0)
  DMA_K(0,0);DMA_V(0,0);DMA_K(1,SLOTB);
  bf16x8 qr[4];
  #pragma unroll
  for(int d0=0;d0<4;++d0)qr[d0]=*reinterpret_cast<const bf16x8*>(&Qw[(long)r32*ZP+d0*16+hi*8]);
  const int qrel=wid*QBLK+r32;
  float mhat=__builtin_ceilf(slope2*(float)(qrel+1))+16.f,l_reg=0.f;f32x16 o[4];o[0]=f32x16{};o[1]=f32x16{};o[2]=f32x16{};o[3]=f32x16{}; SETM();
  #define CMASK(P0,P1,t) do{int jb_=(t)-(NT-4); if(jb_>=0)cmask(P0,P1,jb_,qrel,hi);}while(0)
  bool resc=false;
  #define START(P0,P1) do{ const float rm=rowmax(P0,P1); resc=false; \
    { const float dl=__builtin_ceilf(__builtin_fmaxf(rm,0.f)); mhat=fadd_s(mhat,dl); \
      _Pragma("unroll") for(int r=0;r<16;++r){P0[r]=fsub_s(P0[r],dl);P1[r]=fsub_s(P1[r],dl);} \
      SETM(); } \
    _Pragma("unroll") for(int r=0;r<16;++r)P0[r]=__builtin_amdgcn_exp2f(P0[r]); }while(0)
  #define RESC() do{ if(resc){ asm volatile("s_waitcnt lgkmcnt(0)":::"memory"); \
      _Pragma("unroll") for(int d_=0;d_<4;++d_) _Pragma("unroll") for(int r=0;r<16;++r)o[d_][r]*=wsf[crow(r,hi)]; } }while(0)
  f32x16 pA0,pA1,pB0,pB1;
  int sl_prev=0,sl_cur=0,sl_next=SLOTB;
  #define ROT() do{sl_prev=sl_cur;sl_cur=sl_next;sl_next=(sl_next==(NSLOT-1)*SLOTB)?0:sl_next+SLOTB;}while(0)
  DMA_K(2,2*SLOTB);
  WAIT_BAR(4);
  { const unsigned tb0_=TRB(0); const f32x16 c0_=BIASC(0,kbA0,locA,tb0_), c1_=BIASC(0,kbB0,locB,tb0_); qkt(pA0,pA1,Kbase,qr,c0_,c1_,r32,hi); } asm volatile("s_nop 15\n\ts_nop 7":"+v"(pA0),"+v"(pA1));CMASK(pA0,pA1,0);
  START(pA0,pA1);
  _Pragma("unroll") for(int r=0;r<16;++r)pA1[r]=__builtin_amdgcn_exp2f(pA1[r]);
  WAIT_BAR(0);
  DMA_K(3,0);DMA_V(1,SLOTB);
  ROT();
  kload8(kf,kp0+sl_cur);
  WAIT_BAR(3);
  s16x4 vlo[8],vhi[8]; u32x4 pw0,pw1,pw2,pw3;
  #define PKW(P,B) cvtpk_s(P[B],P[B+1])
  #define PAF(k) __builtin_bit_cast(bf16x8,pw##k)
  #define VFR(i) (bf16x8){vlo[i][0],vlo[i][1],vlo[i][2],vlo[i][3],vhi[i][0],vhi[i][1],vhi[i][2],vhi[i][3]}
  #define PIN(x) asm volatile("":"+v"(x))
  #define MX3(a,b,c) __builtin_fmaxf(__builtin_fmaxf((a),(b)),(c))
  #define GAPA(MF,A0,A1,A2,A3,W0,W1,PW) do{ MF; sacc+=A0; sacc+=A1; sacc+=A2; sacc+=A3; PIN(sacc); W0; W1; PIN(PW); SBAR(); }while(0)
  #define EX(v) __builtin_amdgcn_exp2f(v)
  #define GAPB(MF,X,B) do{ MF; X[B]=EX(X[B]); X[B+1]=EX(X[B+1]); X[B+2]=EX(X[B+2]); X[B+3]=EX(X[B+3]); PIN(X); SBAR(); }while(0)
  #define VRD(s_,db_,ks_) do{ vlo[s_]=vtr(vp_+((db_)*4096+(ks_)*1024)); vhi[s_]=vtr(vp_+((db_)*4096+(ks_)*1024+512)); }while(0)
  #define GAPB2(MF,X,B) do{ MF; X[B]=EX(X[B]); X[B+1]=EX(X[B+1]); PIN(X); SBAR(); }while(0)
  #define KRD(G,j) do{ if(G){ kload2(kf,kp0+sl_next,j); SBAR(); } }while(0)
  #define STEP(C0,C1,P0,P1,t,GK,GV,GL) do{ SBAR(); \
    const lds_cptr vp_=vp0+2*sl_prev; \
    const unsigned tb_=TRB(t); \
    VRD(0,0,0); SBAR(); float sacc=(P0[0]+P0[1]); \
    GAPA(C0=__builtin_amdgcn_mfma_f32_32x32x16_bf16(kf[0],qr[0],BIASC(t,kbA0,locA,tb_),0,0,0), P0[2],P0[3],P0[4],P0[5],     pw0[0]=PKW(P0,0), pw0[1]=PKW(P0,2), pw0); \
    VRD(1,1,0); SBAR(); GAPA(C1=__builtin_amdgcn_mfma_f32_32x32x16_bf16(kf[1],qr[0],BIASC(t,kbB0,locB,tb_),0,0,0), P0[6],P0[7],P0[8],P0[9],     pw0[2]=PKW(P0,4), pw0[3]=PKW(P0,6), pw0); \
    VRD(2,2,0); SBAR(); GAPA(C0=__builtin_amdgcn_mfma_f32_32x32x16_bf16(kf[2],qr[1],C0,0,0,0),   P0[10],P0[11],P0[12],P0[13], pw1[0]=PKW(P0,8), pw1[1]=PKW(P0,10), pw1); \
    VRD(3,3,0); SBAR(); GAPA(C1=__builtin_amdgcn_mfma_f32_32x32x16_bf16(kf[3],qr[1],C1,0,0,0),   P0[14],P0[15],P1[0],P1[1],   pw1[2]=PKW(P0,12),pw1[3]=PKW(P0,14), pw1); \
    VRD(4,0,1); SBAR(); GAPA(C0=__builtin_amdgcn_mfma_f32_32x32x16_bf16(kf[4],qr[2],C0,0,0,0),   P1[2],P1[3],P1[4],P1[5],     pw2[0]=PKW(P1,0), pw2[1]=PKW(P1,2), pw2); \
    VRD(5,1,1); SBAR(); GAPA(C1=__builtin_amdgcn_mfma_f32_32x32x16_bf16(kf[5],qr[2],C1,0,0,0),   P1[6],P1[7],P1[8],P1[9],     pw2[2]=PKW(P1,4), pw2[3]=PKW(P1,6), pw2); \
    VRD(6,2,1); SBAR(); GAPA(C0=__builtin_amdgcn_mfma_f32_32x32x16_bf16(kf[6],qr[3],C0,0,0,0),   P1[10],P1[11],P1[12],P1[13], pw3[0]=PKW(P1,8), pw3[1]=PKW(P1,10), pw3); \
    VRD(7,3,1); SBAR(); GAPA(C1=__builtin_amdgcn_mfma_f32_32x32x16_bf16(kf[7],qr[3],C1,0,0,0),   P1[14],P1[15],0.f,0.f,       pw3[2]=PKW(P1,12),pw3[3]=PKW(P1,14), pw3); \
    l_reg+=sacc; \
    if(GK){DMA_K((t)+3,sl_cur);} if(GV){DMA_V((t)+1,sl_next);} \
    CMASK(C0,C1,t); \
    { float a=MX3(C0[0],C0[1],C1[0]),b=MX3(C0[2],C0[3],C1[1]); a=MX3(a,C1[2],C1[3]); \
      _Pragma("unroll") for(int r=4;r<16;r+=4){a=MX3(a,C0[r],C0[r+1]);b=MX3(b,C0[r+2],C0[r+3]);a=MX3(a,C1[r],C1[r+1]);b=MX3(b,C1[r+2],C1[r+3]);} \
      float rm=__builtin_fmaxf(a,b); { auto rr=__builtin_amdgcn_permlane32_swap(__float_as_uint(rm),__float_as_uint(rm),false,false); rm=__builtin_fmaxf(__uint_as_float(rr[0]),__uint_as_float(rr[1])); } \
      resc=false; \
      if(__builtin_expect(__any(rm>(float)THRL),0)){ const float dl=__builtin_ceilf(__builtin_fmaxf(rm,0.f)); mhat+=dl; \
        _Pragma("unroll") for(int r=0;r<16;++r){C0[r]-=dl;C1[r]-=dl;} \
        SETM(); \
        const float f=__builtin_amdgcn_exp2f(-dl); l_reg*=f; if(hi==0)wsf[r32]=f; resc=true; } } \
    SBAR(); \
    GAPB2(o[0]=__builtin_amdgcn_mfma_f32_32x32x16_bf16(PAF(0),VFR(0),o[0],0,0,0), C0,0); VRD(0,0,2); SBAR(); \
    GAPB2(o[1]=__builtin_amdgcn_mfma_f32_32x32x16_bf16(PAF(0),VFR(1),o[1],0,0,0), C0,2); VRD(1,1,2); SBAR(); \
    GAPB2(o[2]=__builtin_amdgcn_mfma_f32_32x32x16_bf16(PAF(0),VFR(2),o[2],0,0,0), C0,4); VRD(2,2,2); SBAR(); \
    GAPB2(o[3]=__builtin_amdgcn_mfma_f32_32x32x16_bf16(PAF(0),VFR(3),o[3],0,0,0), C0,6); VRD(3,3,2); SBAR(); \
    GAPB2(o[0]=__builtin_amdgcn_mfma_f32_32x32x16_bf16(PAF(1),VFR(4),o[0],0,0,0), C0,8); VRD(4,0,3); SBAR(); \
    GAPB2(o[1]=__builtin_amdgcn_mfma_f32_32x32x16_bf16(PAF(1),VFR(5),o[1],0,0,0), C0,10); VRD(5,1,3); SBAR(); \
    GAPB2(o[2]=__builtin_amdgcn_mfma_f32_32x32x16_bf16(PAF(1),VFR(6),o[2],0,0,0), C0,12); VRD(6,2,3); SBAR(); \
    GAPB2(o[3]=__builtin_amdgcn_mfma_f32_32x32x16_bf16(PAF(1),VFR(7),o[3],0,0,0), C0,14); VRD(7,3,3); SBAR(); \
    KRD(GL,0); GAPB2(o[0]=__builtin_amdgcn_mfma_f32_32x32x16_bf16(PAF(2),VFR(0),o[0],0,0,0), C1,0); \
    KRD(GL,1); GAPB2(o[1]=__builtin_amdgcn_mfma_f32_32x32x16_bf16(PAF(2),VFR(1),o[1],0,0,0), C1,2); \
    KRD(GL,2); GAPB2(o[2]=__builtin_amdgcn_mfma_f32_32x32x16_bf16(PAF(2),VFR(2),o[2],0,0,0), C1,4); \
    KRD(GL,3); GAPB2(o[3]=__builtin_amdgcn_mfma_f32_32x32x16_bf16(PAF(2),VFR(3),o[3],0,0,0), C1,6); \
    GAPB2(o[0]=__builtin_amdgcn_mfma_f32_32x32x16_bf16(PAF(3),VFR(4),o[0],0,0,0), C1,8); \
    GAPB2(o[1]=__builtin_amdgcn_mfma_f32_32x32x16_bf16(PAF(3),VFR(5),o[1],0,0,0), C1,10); \
    GAPB2(o[2]=__builtin_amdgcn_mfma_f32_32x32x16_bf16(PAF(3),VFR(6),o[2],0,0,0), C1,12); \
    GAPB2(o[3]=__builtin_amdgcn_mfma_f32_32x32x16_bf16(PAF(3),VFR(7),o[3],0,0,0), C1,14); \
    }while(0)
  int t=1;
  #undef CMASK
  #define CMASK(P0,P1,t) do{}while(0)
  for(;t+5<NT;t+=2){
    STEP(pB0,pB1,pA0,pA1,t,true,true,true);     WAIT_BAR(3); RESC(); ROT();
    STEP(pA0,pA1,pB0,pB1,t+1,true,true,true);   WAIT_BAR(3); RESC(); ROT();
  }
  #undef CMASK
  #define CMASK(P0,P1,t) do{int jb_=(t)-(NT-4); if(jb_>=0)cmask(P0,P1,jb_,qrel,hi);}while(0)
  #define ENDW(tt) do{ if((tt)+3<NT){WAIT_BAR(3);} else if((tt)+2<NT){WAIT_BAR(2);} else {WAIT_BAR(0);} }while(0)
  for(;t+1<NT;t+=2){
    STEP(pB0,pB1,pA0,pA1,t,(t+3<NT),(t+1<NT),(t+1<NT));       ENDW(t);   RESC(); ROT();
    STEP(pA0,pA1,pB0,pB1,t+1,(t+4<NT),(t+2<NT),(t+2<NT));     ENDW(t+1); RESC(); ROT();
  }
  STEP(pB0,pB1,pA0,pA1,NT-1,false,false,false); RESC();
  { float sacc=pB0[0]+pB0[1]; _Pragma("unroll") for(int r=2;r<16;++r)sacc+=pB0[r]; _Pragma("unroll") for(int r=0;r<16;++r)sacc+=pB1[r]; l_reg+=sacc;
    pw0=(u32x4){PKW(pB0,0),PKW(pB0,2),PKW(pB0,4),PKW(pB0,6)};pw1=(u32x4){PKW(pB0,8),PKW(pB0,10),PKW(pB0,12),PKW(pB0,14)};pw2=(u32x4){PKW(pB1,0),PKW(pB1,2),PKW(pB1,4),PKW(pB1,6)};pw3=(u32x4){PKW(pB1,8),PKW(pB1,10),PKW(pB1,12),PKW(pB1,14)};
    SBAR(); pv(o,vb0+2*sl_cur,PAF(0),PAF(1),PAF(2),PAF(3)); }
  #undef PKW
  #undef PAF
  #undef VFR
  #undef PIN
  #undef MX3
  #undef GAPA
  #undef GAPB
  #undef GAPB2
  #undef EX
  #undef VRD
  #undef KRD
  #undef STEP
  #undef ENDW
  {auto rr=__builtin_amdgcn_permlane32_swap(__float_as_uint(l_reg),__float_as_uint(l_reg),false,false);l_reg=__uint_as_float(rr[0])+__uint_as_float(rr[1]);}
  if(hi==0)wsf[32+r32]=l_reg;asm volatile("s_waitcnt lgkmcnt(0)":::"memory");
  float rli[16];
  #pragma unroll
  for(int r=0;r<16;++r)rli[r]=__builtin_amdgcn_rcpf(wsf[32+crow(r,hi)]);
  bf16*Ow=O+(rowbase+q0+wid*QBLK)*OP;
  { bf16*stg=(bf16*)(shm+LDS_OST)+wid*4096;
    #pragma unroll
    for(int r=0;r<16;++r){const int orow=crow(r,hi);
      #pragma unroll
      for(int d0=0;d0<4;++d0)stg[orow*128+d0*32+r32]=__float2bfloat16(o[d0][r]*rli[r]);}
    asm volatile("s_waitcnt lgkmcnt(0)":::"memory");
    if(F_fmode==1){
      const __amdgpu_buffer_rsrc_t orr=__builtin_amdgcn_make_buffer_rsrc((void*)Ow,0,0x7fffffff,0x00020000);
      #pragma unroll
      for(int i=0;i<8;++i){const int row=i*4+(lane>>4),ch=lane&15; const u32x4 v=*(const u32x4*)(stg+row*128+ch*8); __builtin_amdgcn_raw_buffer_store_b128(v,orr,(unsigned)((row*OP+ch*8)*2),0,16);}
      asm volatile("s_waitcnt vmcnt(0) lgkmcnt(0)\n\ts_barrier":::"memory");
      if(tid==0)__hip_atomic_store(F_flag,1u,__ATOMIC_RELAXED,__HIP_MEMORY_SCOPE_AGENT);
    } else {
      if(tid==0){ unsigned sp_=0; while(__hip_atomic_load(F_flag,__ATOMIC_RELAXED,__HIP_MEMORY_SCOPE_AGENT)==0u){ __builtin_amdgcn_s_sleep(2); if(++sp_>(1u<<22))break; }
        __builtin_amdgcn_fence(__ATOMIC_ACQUIRE,"agent"); asm volatile("s_waitcnt vmcnt(0)":::"memory"); }
      asm volatile("s_waitcnt lgkmcnt(0)\n\ts_barrier":::"memory");
      const int ch=lane&15; const float*sgp=F_sg+8*ch; const float gs=F_gscale,lam=F_lam;
      const f32x4_t g0=*(const f32x4_t*)sgp*gs,g1=*(const f32x4_t*)(sgp+4)*gs;
      unsigned short*mo=F_mixo+(rowbase+q0+wid*QBLK)*1024;
      u32x4 pv_[8];
      #pragma unroll
      for(int i=0;i<8;++i){const int row=i*4+(lane>>4); pv_[i]=*(const u32x4*)(Ow+(long)row*OP+ch*8);}
      #pragma unroll
      for(int i=0;i<8;++i){const int row=i*4+(lane>>4); const u32x4 a=*(const u32x4*)(stg+row*128+ch*8),c=pv_[i];
        #define BLO(w) __uint_as_float((w)<<16)
        #define BHI(w) __uint_as_float((w)&0xffff0000u)
        const f32x4_t v0=(f32x4_t){BLO(a.x),BHI(a.x),BLO(a.y),BHI(a.y)}-lam*(f32x4_t){BLO(c.x),BHI(c.x),BLO(c.y),BHI(c.y)};
        const f32x4_t v1=(f32x4_t){BLO(a.z),BHI(a.z),BLO(a.w),BHI(a.w)}-lam*(f32x4_t){BLO(c.z),BHI(c.z),BLO(c.w),BHI(c.w)};
        #undef BLO
        #undef BHI
        float sq=(v0[0]*v0[0]+v0[1]*v0[1])+(v0[2]*v0[2]+v0[3]*v0[3])+(v1[0]*v1[0]+v1[1]*v1[1])+(v1[2]*v1[2]+v1[3]*v1[3]);
        #pragma unroll
        for(int m_=1;m_<16;m_<<=1) sq+=__builtin_bit_cast(float,__builtin_amdgcn_ds_bpermute((lane^m_)<<2,__builtin_bit_cast(int,sq)));
        const float rstd=__builtin_amdgcn_rsqf(sq*(1.0f/128.0f)+1e-5f);
        const f32x4_t o0=v0*rstd*g0,o1=v1*rstd*g1;
        u32x4 w; w.x=cvtpk_s(o0[0],o0[1]); w.y=cvtpk_s(o0[2],o0[3]); w.z=cvtpk_s(o1[0],o1[1]); w.w=cvtpk_s(o1[2],o1[3]);
        *(u32x4*)(mo+(long)row*1024+ch*8)=w; }
      asm volatile("s_waitcnt lgkmcnt(0)\n\ts_barrier":::"memory");
    } }
  #undef DMA_K
  #undef TRB
  #undef SETM
  #undef KBIAS
  #undef BIASC
  #undef DMA_V
  #undef CMASK
  #undef START
  #undef RESC
  #undef ROT
}
constexpr int ATTN_LDS_BYTES=LDS_BYTES;
#undef SBAR
#undef WAIT_BAR
}

namespace sgu {
constexpr int SP = 136;
constexpr int HALF_LDS = 128 * SP * 2 + 512;
__device__ __forceinline__ void unit2(LAS unsigned char* lds, const bf16_t* z, bf16_t* mix, const float* ln_g, const float* ln_b, const float* w_s, const float* b_s, int itA, int itB) {
    int tid_ = threadIdx.x; asm volatile("" : "+v"(tid_));
    const int tid = tid_, lane = tid & 63, r32 = lane & 31, hi = lane >> 5; const int wid = __builtin_amdgcn_readfirstlane(tid >> 6);
    const int half = wid >> 2, tl = tid & 255, tb = wid & 3;
    const int it = half ? itB : itA; const bool act = it >= 0;
    const int chunk = act ? it >> 2 : 0, g = act ? it & 3 : 0;
    const size_t row0 = (size_t)chunk * 128;
    LAS bf16_t* Vt = (LAS bf16_t*)(lds + half * HALF_LDS);
    const int t = 32 * tb + r32, nks = 2 * tb + 2;
    const float* wrow = w_s + ((size_t)g * 128 + t) * 128 + 8 * hi;
    f32x4 wa[8], wb[8];
#pragma unroll
    for (int ks = 0; ks < 8; ++ks) { if (act && ks < nks) { wa[ks] = *(const f32x4*)(wrow + 16 * ks); wb[ks] = *(const f32x4*)(wrow + 16 * ks + 4); } else { wa[ks] = (f32x4){0.f, 0.f, 0.f, 0.f}; wb[ks] = wa[ks]; } }
    const float bias = b_s[g * 128 + t];
    const bf16_t* up = z + (row0 + t) * DIN + 1536 + g * 128 + 4 * hi; bf16_t* op = mix + (row0 + t) * D + 512 + g * 128 + 4 * hi;
    if (act) {
        const int s = tl >> 1, qd = tl & 1; const bf16_t* src = z + (row0 + s) * DIN + 2048 + g * 128 + 64 * qd;
        float v[64]; float sum = 0.f;
#pragma unroll
        for (int j = 0; j < 8; ++j) { const u32x4 w = *(const u32x4*)(src + 8 * j);
#pragma unroll
            for (int e = 0; e < 4; ++e) { const float a = gelu_t(bflo(w[e])), c = gelu_t(bfhi(w[e])); v[8 * j + 2 * e] = a; v[8 * j + 2 * e + 1] = c; sum += a + c; } }
        sum += shx(sum, 1, lane);
        const float mean = sum * (1.0f / 128.0f); float sq = 0.f;
#pragma unroll
        for (int j = 0; j < 64; ++j) { v[j] -= mean; sq += v[j] * v[j]; }
        sq += shx(sq, 1, lane);
        const float rstd = __builtin_amdgcn_rsqf(sq * (1.0f / 128.0f) + LN_EPS);
        const float* gp = ln_g + g * 128 + 64 * qd; const float* bp = ln_b + g * 128 + 64 * qd;
#pragma unroll
        for (int j = 0; j < 64; ++j) Vt[(64 * qd + j) * SP + s] = (bf16_t)f2bf(v[j] * rstd * gp[j] + bp[j]);
    }
    __syncthreads();
    if (act) {
        f32x16 acc[4]; acc[0] = f32x16{}; acc[1] = f32x16{}; acc[2] = f32x16{}; acc[3] = f32x16{};
#pragma unroll
        for (int ks = 0; ks < 8; ++ks) if (ks < nks) {
            const int s0 = 16 * ks + 8 * hi;
            u32x4 w; w.x = pk2(s0 <= t ? wa[ks][0] : 0.f, s0 + 1 <= t ? wa[ks][1] : 0.f); w.y = pk2(s0 + 2 <= t ? wa[ks][2] : 0.f, s0 + 3 <= t ? wa[ks][3] : 0.f);
            w.z = pk2(s0 + 4 <= t ? wb[ks][0] : 0.f, s0 + 5 <= t ? wb[ks][1] : 0.f); w.w = pk2(s0 + 6 <= t ? wb[ks][2] : 0.f, s0 + 7 <= t ? wb[ks][3] : 0.f);
            const bf16x8 bfrag = __builtin_bit_cast(bf16x8, w);
#pragma unroll
            for (int cc = 0; cc < 4; ++cc) { const bf16x8 af = *(const LAS bf16x8*)(Vt + (32 * cc + r32) * SP + 16 * ks + 8 * hi);
                acc[cc] = __builtin_amdgcn_mfma_f32_32x32x16_bf16(af, bfrag, acc[cc], 0, 0, 0); }
        }
#pragma unroll
        for (int cc = 0; cc < 4; ++cc) {
            u32x2 uw[4];
#pragma unroll
            for (int q4 = 0; q4 < 4; ++q4) uw[q4] = *(const u32x2*)(up + 32 * cc + 8 * q4);
#pragma unroll
            for (int q4 = 0; q4 < 4; ++q4) { const u32x2 u2 = uw[q4];
                const float o0 = gelu_t(bflo(u2.x)) * (acc[cc][4 * q4] + bias), o1 = gelu_t(bfhi(u2.x)) * (acc[cc][4 * q4 + 1] + bias);
                const float o2 = gelu_t(bflo(u2.y)) * (acc[cc][4 * q4 + 2] + bias), o3 = gelu_t(bfhi(u2.y)) * (acc[cc][4 * q4 + 3] + bias);
                u32x2 w; w.x = cvtpk(o0, o1); w.y = cvtpk(o2, o3); *(u32x2*)(op + 32 * cc + 8 * q4) = w; }
        }
    }
    __syncthreads();
}
constexpr int QUARTER_LDS = 128 * SP * 2 + 512;
__device__ __forceinline__ void unit4(LAS unsigned char* lds, const bf16_t* z, bf16_t* mix, const float* ln_g, const float* ln_b, const float* w_s, const float* b_s, int it0, int it1, int it2, int it3) {
    int tid_ = threadIdx.x; asm volatile("" : "+v"(tid_));
    const int tid = tid_, lane = tid & 63, r32 = lane & 31, hi = lane >> 5; const int wid = __builtin_amdgcn_readfirstlane(tid >> 6);
    const int qt = wid >> 1, wq = wid & 1, tq = tid & 127;
    const int it = qt == 0 ? it0 : qt == 1 ? it1 : qt == 2 ? it2 : it3; const bool act = it >= 0;
    const int chunk = act ? it >> 2 : 0, g = act ? it & 3 : 0;
    const size_t row0 = (size_t)chunk * 128;
    LAS bf16_t* Vt = (LAS bf16_t*)(lds + qt * QUARTER_LDS);
    if (act) {
        const bf16_t* src = z + (row0 + tq) * DIN + 2048 + g * 128;
        unsigned vp[64]; float sum = 0.f, sq = 0.f;
#pragma unroll
        for (int j = 0; j < 16; ++j) { const u32x4 w = *(const u32x4*)(src + 8 * j);
#pragma unroll
            for (int e = 0; e < 4; ++e) { const f32x2 gv = gelu_t2((f32x2){bflo(w[e]), bfhi(w[e])}); vp[4 * j + e] = cvtpk(gv.x, gv.y); sum += gv.x + gv.y; sq += gv.x * gv.x + gv.y * gv.y; } }
        const float mean = sum * (1.0f / 128.0f);
        const float rstd = __builtin_amdgcn_rsqf(fmaxf(sq * (1.0f / 128.0f) - mean * mean, 0.f) + LN_EPS);
        const float* gp = ln_g + g * 128; const float* bp = ln_b + g * 128;
#pragma unroll
        for (int j = 0; j < 64; ++j) { const f32x2 nv = (((f32x2){bflo(vp[j]), bfhi(vp[j])} - mean) * rstd) * (f32x2){gp[2 * j], gp[2 * j + 1]} + (f32x2){bp[2 * j], bp[2 * j + 1]};
            const unsigned w = cvtpk(nv.x, nv.y);
            Vt[(2 * j) * SP + tq] = (bf16_t)(w & 0xffffu); Vt[(2 * j + 1) * SP + tq] = (bf16_t)(w >> 16); }
    }
    __syncthreads();
    if (act) {
#pragma unroll
        for (int pass = 0; pass < 2; ++pass) {
            const int tb = pass == 0 ? (wq ? 1 : 0) : (wq ? 2 : 3); const int t = 32 * tb + r32, nks = 2 * tb + 2;
            const float* wrow = w_s + ((size_t)g * 128 + t) * 128 + 8 * hi;
            f32x4 wa[8], wb[8];
#pragma unroll
            for (int ks = 0; ks < 8; ++ks) { if (ks < nks) { wa[ks] = *(const f32x4*)(wrow + 16 * ks); wb[ks] = *(const f32x4*)(wrow + 16 * ks + 4); } else { wa[ks] = (f32x4){0.f, 0.f, 0.f, 0.f}; wb[ks] = wa[ks]; } }
            const float bias = b_s[g * 128 + t];
            const bf16_t* up = z + (row0 + t) * DIN + 1536 + g * 128 + 4 * hi; bf16_t* op = mix + (row0 + t) * D + 512 + g * 128 + 4 * hi;
            u32x2 uw[16];
#pragma unroll
            for (int j = 0; j < 16; ++j) uw[j] = *(const u32x2*)(up + 8 * j);
            f32x16 acc[4]; acc[0] = f32x16{}; acc[1] = f32x16{}; acc[2] = f32x16{}; acc[3] = f32x16{};
#pragma unroll
            for (int ks = 0; ks < 8; ++ks) if (ks < nks) {
                const int s0 = 16 * ks + 8 * hi;
                u32x4 w; w.x = pk2(s0 <= t ? wa[ks][0] : 0.f, s0 + 1 <= t ? wa[ks][1] : 0.f); w.y = pk2(s0 + 2 <= t ? wa[ks][2] : 0.f, s0 + 3 <= t ? wa[ks][3] : 0.f);
                w.z = pk2(s0 + 4 <= t ? wb[ks][0] : 0.f, s0 + 5 <= t ? wb[ks][1] : 0.f); w.w = pk2(s0 + 6 <= t ? wb[ks][2] : 0.f, s0 + 7 <= t ? wb[ks][3] : 0.f);
                const bf16x8 bfrag = __builtin_bit_cast(bf16x8, w);
#pragma unroll
                for (int cc = 0; cc < 4; ++cc) { const bf16x8 af = *(const LAS bf16x8*)(Vt + (32 * cc + r32) * SP + 16 * ks + 8 * hi);
                    acc[cc] = __builtin_amdgcn_mfma_f32_32x32x16_bf16(af, bfrag, acc[cc], 0, 0, 0); }
            }
#pragma unroll
            for (int cc = 0; cc < 4; ++cc)
#pragma unroll
                for (int q4 = 0; q4 < 4; ++q4) { const u32x2 u2 = uw[4 * cc + q4];
                    const f32x2 oa = gelu_t2((f32x2){bflo(u2.x), bfhi(u2.x)}) * ((f32x2){acc[cc][4 * q4], acc[cc][4 * q4 + 1]} + bias);
                    const f32x2 ob = gelu_t2((f32x2){bflo(u2.y), bfhi(u2.y)}) * ((f32x2){acc[cc][4 * q4 + 2], acc[cc][4 * q4 + 3]} + bias);
                    u32x2 w; w.x = cvtpk(oa.x, oa.y); w.y = cvtpk(ob.x, ob.y); *(u32x2*)(op + 32 * cc + 8 * q4) = w; }
        }
    }
    __syncthreads();
}
}
constexpr int CV_IN = (D / 64) * (DIN / 32), CV_OUT = (D / 64) * (D / 32), CV_UP = (D / 64) * (NUP / 32), CV_DN = (DFF / 64) * (D / 32), CV_L = CV_IN + CV_OUT + CV_UP + CV_DN;
struct CvPtrs { const float *w_in, *norm1_g, *w_out, *w_up, *norm2_g, *w_down; };
__device__ __forceinline__ void cv_desc(int gi, const float* w_in, const float* norm1_g, const float* w_out, const float* w_up, const float* norm2_g, const float* w_down, unsigned char* ws,
                                        const float*& W, const float*& gk, bf16_t*& WT, int& K, int& N, int& k0, int& n0, int& mode) {
    const int l = gi / CV_L; int r = gi % CV_L; unsigned char* wl = ws + WS_W + l * W_LAYER;
    if (r < CV_IN) { W = w_in + (size_t)l * D * DIN; gk = norm1_g + l * D; WT = (bf16_t*)(wl + W_IN); K = D; N = DIN; mode = 1; }
    else if ((r -= CV_IN) < CV_OUT) { W = w_out + (size_t)l * D * D; gk = nullptr; WT = (bf16_t*)(wl + W_OUT); K = D; N = D; mode = 0; }
    else if ((r -= CV_OUT) < CV_UP) { W = w_up + (size_t)l * D * NUP; gk = norm2_g + l * D; WT = (bf16_t*)(wl + W_UP); K = D; N = NUP; mode = 2; }
    else { r -= CV_UP; W = w_down + (size_t)l * DFF * D; gk = nullptr; WT = (bf16_t*)(wl + W_DOWN); K = DFF; N = D; mode = 0; }
    const int nblk = N / 32; k0 = 64 * (r / nblk); n0 = 32 * (r % nblk);
}
__device__ __forceinline__ void cv_load(float (&wv)[32], const float* W, int N, int k0, int n0, int lane) {
#pragma unroll
    for (int i = 0; i < 32; ++i) wv[i] = __builtin_nontemporal_load(W + (size_t)(k0 + 2 * i + (lane >> 5)) * N + n0 + (lane & 31));
}
__device__ __forceinline__ void cv_finish(const float (&wv)[32], const float* gk, bf16_t* WT, int K, int k0, int n0, int mode, LAS float* scr, int lane) {
    const float cs = (mode == 1 && n0 < 512) ? QSCALE : 1.0f;
#pragma unroll
    for (int i = 0; i < 32; ++i) { const int kk = 2 * i + (lane >> 5); float v = wv[i];
        if (mode != 0) v *= gk[k0 + kk] * cs;
        scr[kk * 33 + (lane & 31)] = v; }
    asm volatile("s_waitcnt lgkmcnt(0)" ::: "memory");
    const int c = lane & 7;
    int d0 = n0;
    if (mode == 2) { const int half = n0 >= DFF ? 1 : 0, cc = n0 - half * DFF; d0 = 256 * (cc >> 7) + 128 * half + (cc & 127); }
#pragma unroll
    for (int j = 0; j < 4; ++j) { const int n = (lane >> 3) + 8 * j; const LAS float* s = scr + (8 * c) * 33 + n;
        u32x4 o; o.x = pk2(s[0 * 33], s[1 * 33]); o.y = pk2(s[2 * 33], s[3 * 33]); o.z = pk2(s[4 * 33], s[5 * 33]); o.w = pk2(s[6 * 33], s[7 * 33]);
        *(u32x4*)(WT + (size_t)(d0 + n) * K + k0 + 8 * c) = o; }
    asm volatile("s_waitcnt lgkmcnt(0)" ::: "memory");
}
__device__ __forceinline__ void convert_weights(const float* w_in, const float* norm1_g, const float* w_out, const float* w_up, const float* norm2_g, const float* w_down, unsigned char* ws, LAS float* scr, int lane, int first, int stride, int total) {
    if (first >= total) return;
    const float *W, *gk; bf16_t* WT; int K, N, k0, n0, mode; float wv[32];
    cv_desc(first, w_in, norm1_g, w_out, w_up, norm2_g, w_down, ws, W, gk, WT, K, N, k0, n0, mode);
    cv_load(wv, W, N, k0, n0, lane);
    for (int gi = first;;) {
        const int g2 = gi + stride; const bool has = g2 < total;
        const float *W2 = W, *gk2 = gk; bf16_t* WT2 = WT; int K2 = K, N2 = N, k02 = k0, n02 = n0, mode2 = mode; float wv2[32];
        if (has) { cv_desc(g2, w_in, norm1_g, w_out, w_up, norm2_g, w_down, ws, W2, gk2, WT2, K2, N2, k02, n02, mode2); cv_load(wv2, W2, N2, k02, n02, lane); }
        cv_finish(wv, gk, WT, K, k0, n0, mode, scr, lane);
        if (!has) break;
        W = W2; gk = gk2; WT = WT2; K = K2; N = N2; k0 = k02; n0 = n02; mode = mode2; gi = g2;
#pragma unroll
        for (int i = 0; i < 32; ++i) wv[i] = wv2[i];
    }
}

#define XB_TMO      128
#define XB_XCNT(j)  (256  + 64 * (j))
#define XB_XSUB(j)  (1280 + 64 * (j))
#define XB_XGEN(j)  (2304 + 64 * (j))
#define XB_TOP      3328
#define XB_TOPGEN   3392
#define XCD_BAR_WORDS 3456
#define XB_SPIN_CAP (1u << 18)

__device__ __forceinline__ unsigned xb_ld(unsigned* p)              { return __hip_atomic_load(p, __ATOMIC_RELAXED, __HIP_MEMORY_SCOPE_AGENT); }
__device__ __forceinline__ unsigned xb_add(unsigned* p, unsigned v) { return __hip_atomic_fetch_add(p, v, __ATOMIC_RELAXED, __HIP_MEMORY_SCOPE_AGENT); }
__device__ __forceinline__ unsigned xb_xcc_id() { return (unsigned)__builtin_amdgcn_s_getreg((3 << 11) | 20) & 0xFu; }
#define XB_SPIN(cond, bar) do { unsigned _sp = 0; while (cond) { __builtin_amdgcn_s_sleep(1); \
    if ((++_sp & 255u) == 0u) { if (xb_ld(&(bar)[XB_TMO])) break; if (_sp > XB_SPIN_CAP) { atomicAdd(&(bar)[XB_TMO], 1u); break; } } } } while (0)

struct XcdBarrier {
    unsigned* bar; unsigned x;
    volatile LAS unsigned* st;
};

__device__ __forceinline__ XcdBarrier xcd_barrier_post(unsigned* bar, volatile LAS unsigned* st) {
    XcdBarrier b; b.bar = bar; b.x = xb_xcc_id(); b.st = st;
    if (threadIdx.x == 0) (void)xb_add(&bar[XB_XCNT(b.x)], 1u);
    return b;
}
__device__ __forceinline__ void xcd_barrier_complete(unsigned* bar, unsigned x, unsigned& nloc, unsigned& nx) {
    const unsigned G = gridDim.x * gridDim.y * gridDim.z;
    unsigned sum, cnt, mine, sp = 0u;
    for (;;) {
        sum = 0u; cnt = 0u; mine = 0u;
#pragma unroll
        for (unsigned j = 0; j < 16; ++j) { const unsigned c = xb_ld(&bar[XB_XCNT(j)]); sum += c; cnt += (c > 0u) ? 1u : 0u; mine = (j == x) ? c : mine; }
        if (sum == G) break;
        __builtin_amdgcn_s_sleep(1);
        if ((++sp & 255u) == 0u) { if (xb_ld(&bar[XB_TMO])) break; if (sp > XB_SPIN_CAP) { atomicAdd(&bar[XB_TMO], 1u); break; } }
    }
    nloc = mine > 0u ? mine : 1u; nx = cnt > 0u ? cnt : 1u;
}

__device__ __forceinline__ void xcd_barrier(const XcdBarrier& b) {
    asm volatile("s_waitcnt vmcnt(0)" ::: "memory");
    __syncthreads();
    if (threadIdx.x == 0) {
        unsigned* bar = b.bar;
        __builtin_amdgcn_s_waitcnt(0);
        unsigned nloc = b.st[0], nx = b.st[1];
        if (nloc == 0u) { xcd_barrier_complete(bar, b.x, nloc, nx); b.st[0] = nloc; b.st[1] = nx; }
        const unsigned old = xb_add(&bar[XB_XSUB(b.x)], 1u);
        const unsigned gen = old / nloc;
        if (old + 1u == (gen + 1u) * nloc) {
            __builtin_amdgcn_fence(__ATOMIC_RELEASE, "agent");
            asm volatile("s_waitcnt vmcnt(0)" ::: "memory");
            const unsigned og = xb_add(&bar[XB_TOP], 1u);
            const unsigned tg = og / nx;
            if (og + 1u == (tg + 1u) * nx) xb_add(&bar[XB_TOPGEN], 1u);
            else XB_SPIN(xb_ld(&bar[XB_TOPGEN]) == tg, bar);
            __builtin_amdgcn_fence(__ATOMIC_ACQUIRE, "agent");
            xb_add(&bar[XB_XGEN(b.x)], 1u);
            asm volatile("s_waitcnt vmcnt(0)" ::: "memory");
        } else {
            XB_SPIN(xb_ld(&bar[XB_XGEN(b.x)]) == gen, bar);
            __builtin_amdgcn_fence(__ATOMIC_ACQUIRE, "agent");
            asm volatile("s_waitcnt vmcnt(0)" ::: "memory");
        }
    }
    __syncthreads();
}

struct Params {
    const float *x, *norm1_g, *w_in, *lam_q1, *lam_k1, *lam_q2, *lam_k2, *subln_g, *sgu_ln_g, *sgu_ln_b, *sgu_w, *sgu_b, *w_out, *norm2_g, *ffn_w_up, *ffn_conv_w, *ffn_conv_b, *ffn_w_down, *final_g;
    float* out; unsigned char* ws;
};

#define CAS __attribute__((address_space(4)))
#define LOADP() const CAS Params* pp = (const CAS Params*)__builtin_amdgcn_kernarg_segment_ptr(); asm volatile("" : "+s"(pp)); unsigned char* ws = pp->ws; float* ss = (float*)(ws + WS_SS)
#define GRID_BAR() do { const CAS Params* ppb = (const CAS Params*)__builtin_amdgcn_kernarg_segment_ptr(); asm volatile("" : "+s"(ppb)); XcdBarrier b_; b_.bar = (unsigned*)(ppb->ws + WS_CTL); b_.x = xb_xcc_id(); \
        b_.st = (volatile LAS unsigned*)((LAS unsigned char*)lds_raw + LDS_BYTES - 64); xcd_barrier(b_); } while (0)

template <int l> __device__ __forceinline__ void layer_body(LAS unsigned char* lds, unsigned char* lds_raw, const int G, const int bx, const int vcu) {
#if PH & 1
        {
            LOADP(); unsigned char* wl = ws + WS_W + l * W_LAYER;
            pg8::Gemm g{(const bf16_t*)(ws + WS_XB), (const bf16_t*)(wl + W_IN), M, DIN, D, 256, 128, 0};
            int Gl = G, bxl = bx; asm volatile("" : "+s"(Gl), "+s"(bxl));
            const bool fused = FUSE_SGU && (Gl == 256);
            unsigned* cnt = (unsigned*)(ws + WS_CTL) + 8192 + 64 * l;
            InProjOrder S; S.init(G, bx, cnt, fused);
            fill_rstd<false>(lds, S, ss);
            EpiInProj E{(bf16_t*)(ws + WS_Z), (LAS const float*)(lds + RSTAB_OFF), fused};
            for (int rep = 0; rep < REP_P1; ++rep) pg8::gemm_phase<EpiInProj, InProjOrder, true, true>(lds, g, S, E);
            if (fused && bxl >= 128) {
                if (threadIdx.x == 0) { unsigned sp = 0;
                    while (__hip_atomic_load(cnt, __ATOMIC_RELAXED, __HIP_MEMORY_SCOPE_AGENT) < 256u * REP_P1) { __builtin_amdgcn_s_sleep(2); if (++sp > (1u << 22)) break; }
                    __builtin_amdgcn_fence(__ATOMIC_ACQUIRE, "agent"); asm volatile("s_waitcnt vmcnt(0)" ::: "memory"); }
                __syncthreads();
                const bf16_t* zb = (const bf16_t*)(ws + WS_Z); bf16_t* mix = (bf16_t*)(ws + WS_MIX);
                { const int it = bxl - 128; sgu::unit4(lds, zb, mix, pp->sgu_ln_g + l * 512, pp->sgu_ln_b + l * 512, pp->sgu_w + (size_t)l * 4 * 128 * 128, pp->sgu_b + l * 512, it, it + 128, it + 256, it + 384); }
            }
        }
        GRID_BAR();
#endif
#if PH & 2
        {
            LOADP(); (void)ss; int tid = threadIdx.x; asm volatile("" : "+v"(tid)); const int lane = tid & 63;
            const attn_body::bf16* z = (const attn_body::bf16*)(ws + WS_Z); attn_body::bf16* opart = (attn_body::bf16*)(ws + WS_OP1);
            const int bhr = vcu >> 4, s16 = vcu & 15, b = bhr >> 3, h = (bhr >> 1) & 3, br = bhr & 1;
            const float slope2 = exp2f(-2.0f * (float)(h + 1)) * LOG2E;
            const float lam_init = 0.8f - 0.6f * expf(-0.3f * (float)l);
            const float d1 = wave_sum(pp->lam_q1[l * 64 + lane] * pp->lam_k1[l * 64 + lane], lane), d2 = wave_sum(pp->lam_q2[l * 64 + lane] * pp->lam_k2[l * 64 + lane], lane);
            const float lam = __builtin_bit_cast(float, __builtin_amdgcn_readfirstlane(__builtin_bit_cast(int, expf(d1) - expf(d2) + lam_init)));
            unsigned* flags = (unsigned*)(ws + WS_CTL) + 9216 + ((l * 8 + b * 4 + h) * 32) * 16;
            if (vcu < 256)
                for (int i = 0; i < 2 * REP_ATT; ++i) { const int qb = (i & 1) ? s16 : 31 - s16;
                    attn_body::attn_unit<8>(b, qb, z + h * 128 + br * 64, z + 512 + h * 128 + br * 64, z + 1024 + h * 128, opart + h * 128, (char*)lds_raw, slope2, br, flags + qb * 16, (unsigned short*)(ws + WS_MIX) + h * 128, lam, 1.0f - lam_init, pp->subln_g + l * 128); }
        }
        GRID_BAR();
#endif
#if PH & 4
        {
            LOADP(); (void)ss;
            const bf16_t* zb = (const bf16_t*)(ws + WS_Z); bf16_t* mix = (bf16_t*)(ws + WS_MIX);
            int Gl = G; asm volatile("" : "+s"(Gl));
            if (!FUSE_SGU || Gl != 256) {
                for (int rs_ = 0; rs_ < REP_SGU * REP_P2B; ++rs_)
                for (int it = vcu; it < 512; it += 2 * G) sgu::unit2(lds, zb, mix, pp->sgu_ln_g + l * 512, pp->sgu_ln_b + l * 512, pp->sgu_w + (size_t)l * 4 * 128 * 128, pp->sgu_b + l * 512, it, it + G < 512 ? it + G : -1);
                GRID_BAR();
            }
        }
#endif
#if PH & 8
        {
            LOADP(); unsigned char* wl = ws + WS_W + l * W_LAYER;
            pg8::Gemm g{(const bf16_t*)(ws + WS_MIX), (const bf16_t*)(wl + W_OUT), M, D, D, 256, 128, 0}; pg8::StaticOrder S; S.init(M, D, G, bx);
            EpiRes E{nullptr, (bf16_t*)(ws + WS_XB), ss};
            pg8::gemm_phase<EpiRes, pg8::StaticOrder, true, true>(lds, g, S, E);
        }
        GRID_BAR();
#endif
#if PH & 16
        {
            LOADP(); unsigned char* wl = ws + WS_W + l * W_LAYER;
            pg8::Gemm g{(const bf16_t*)(ws + WS_XB) - 2 * D, (const bf16_t*)(wl + W_UP), P4_TILES * 256, NUP, D, P4_ROWS, P4_ROWS / 2, 2}; pg8::StaticOrder S; S.init(P4_TILES * 256, NUP, G, bx);
            fill_rstd<true>(lds, S, ss);
            EpiConvGate E{(bf16_t*)(ws + WS_Y), (LAS const float*)(lds + RSTAB_OFF), pp->ffn_conv_w + (size_t)l * 3 * NUP, pp->ffn_conv_b + (size_t)l * NUP};
            for (int rep = 0; rep < REP_P4; ++rep) pg8::gemm_phase<EpiConvGate, pg8::StaticOrder, true, true>(lds, g, S, E);
        }
        GRID_BAR();
#endif
#if PH & 32
        {
            LOADP(); unsigned char* wl = ws + WS_W + l * W_LAYER;
            pg8::Gemm g{(const bf16_t*)(ws + WS_Y), (const bf16_t*)(wl + W_DOWN), M, D, DFF, 256, 128, 0}; pg8::StaticOrder S; S.init(M, D, G, bx);
            int Gl = G; asm volatile("" : "+s"(Gl));
            if (l == DEPTH - 1 && Gl == 256) {
                EpiResFinal E{(const bf16_t*)(ws + WS_XB), ss, pp->out, pp->final_g, (unsigned*)(ws + WS_CTL) + 20480, (LAS float*)(lds + RSTAB_OFF)};
                pg8::gemm_phase<EpiResFinal, pg8::StaticOrder, true, true>(lds, g, S, E);
            } else {
                EpiRes E{nullptr, (bf16_t*)(ws + WS_XB), ss};
                pg8::gemm_phase<EpiRes, pg8::StaticOrder, true, true>(lds, g, S, E);
                GRID_BAR();
            }
        }
#endif
}

__global__ void __launch_bounds__(512, 2) fwd_megakernel(Params Punused) {
    extern __shared__ __attribute__((aligned(16))) unsigned char lds_raw[];
    LAS unsigned char* lds = (LAS unsigned char*)lds_raw;
    cg::grid_group grid = cg::this_grid();
    const int G = gridDim.x, bx = blockIdx.x;
    const int vcu = (G % 8 == 0) ? (bx % 8) * (G / 8) + bx / 8 : bx;
    volatile LAS unsigned* bst = (volatile LAS unsigned*)(lds + LDS_BYTES - 64);
    if (threadIdx.x < 2) bst[threadIdx.x] = 0u;
    __syncthreads();
    { const CAS Params* pp0 = (const CAS Params*)__builtin_amdgcn_kernarg_segment_ptr(); (void)xcd_barrier_post((unsigned*)(pp0->ws + WS_CTL), bst); }
    {
        LOADP(); int tid = threadIdx.x; asm volatile("" : "+v"(tid)); const int lane = tid & 63, wave = __builtin_amdgcn_readfirstlane(tid >> 6), gw = vcu * 8 + wave, NGW = G * 8;
        bf16_t* xb = (bf16_t*)(ws + WS_XB);
        LAS float* scr = (LAS float*)(lds + wave * 16384);
        for (int rep = 0; rep < REP_P0; ++rep) {
        convert_weights(pp->w_in, pp->norm1_g, pp->w_out, pp->ffn_w_up, pp->norm2_g, pp->ffn_w_down, ws, scr, lane, gw, NGW, DEPTH * CV_L);
        const float* x = pp->x;
        for (int m0 = gw; m0 < M; m0 += 2 * NGW) {
            f32x4 v[2][4];
#pragma unroll
            for (int k = 0; k < 2; ++k) { const f32x4* xr = (const f32x4*)(x + (size_t)(m0 + k * NGW) * D) + lane;
#pragma unroll
                for (int j = 0; j < 4; ++j) v[k][j] = __builtin_nontemporal_load(xr + 64 * j); }
#pragma unroll
            for (int k = 0; k < 2; ++k) { const int m = m0 + k * NGW; float s = 0.f;
                unsigned long long* o8 = (unsigned long long*)(xb + (size_t)m * D) + lane;
#pragma unroll
                for (int j = 0; j < 4; ++j) { const f32x4 t = v[k][j]; s += (t[0] * t[0] + t[1] * t[1]) + (t[2] * t[2] + t[3] * t[3]);
                    o8[64 * j] = (unsigned long long)pk2(t[0], t[1]) | ((unsigned long long)pk2(t[2], t[3]) << 32); }
                s = wave_sum(s, lane);
                if (lane < 16) ss[(size_t)m * 16 + lane] = lane == 0 ? s : 0.f; }
        }
        }
    }
    if (gridDim.y == 7u) grid.sync();
    GRID_BAR();
    for (int rep = 0; rep < REP_SYNC; ++rep) GRID_BAR();

    layer_body<0>(lds, lds_raw, G, bx, vcu);
    layer_body<1>(lds, lds_raw, G, bx, vcu);
    if (G != 256) {
        LOADP(); int tid = threadIdx.x; asm volatile("" : "+v"(tid)); const int lane = tid & 63, wave = __builtin_amdgcn_readfirstlane(tid >> 6), gw = vcu * 8 + wave, NGW = G * 8;
        float* out = pp->out; const f32x4* gp = (const f32x4*)pp->final_g + lane;
        const bf16_t* xb = (const bf16_t*)(ws + WS_XB);
        f32x4 gv[4];
#pragma unroll
        for (int j = 0; j < 4; ++j) gv[j] = gp[64 * j];
        for (int m0 = gw; m0 < M; m0 += 2 * NGW) {
            u32x2 xv[2][4]; float rs[2];
#pragma unroll
            for (int k = 0; k < 2; ++k) { const int m = m0 + k * NGW; const u32x2* xr = (const u32x2*)(xb + (size_t)m * D) + lane;
#pragma unroll
                for (int j = 0; j < 4; ++j) xv[k][j] = xr[64 * j];
                rs[k] = row_rstd(ss, m, NORM_EPS); }
#pragma unroll
            for (int k = 0; k < 2; ++k) { const int m = m0 + k * NGW; f32x4* xr = (f32x4*)(out + (size_t)m * D) + lane;
#pragma unroll
                for (int j = 0; j < 4; ++j) xr[64 * j] = (f32x4){bflo(xv[k][j].x), bfhi(xv[k][j].x), bflo(xv[k][j].y), bfhi(xv[k][j].y)} * rs[k] * gv[j]; }
        }
    }
}

extern "C" void kernel_launch(void* const* d_in, const int* in_sizes, int n_in, void* d_out, int out_size, void* d_ws, size_t ws_size, hipStream_t stream) {
    static int grid = 0;
    if (grid == 0) {
        if (n_in != 19 || in_sizes[0] != M * D || out_size != M * D || ws_size < WS_END) { fprintf(stderr, "kernel_launch: unexpected shapes (n_in %d, ws %zu)\n", n_in, ws_size); grid = -1; return; }
        int dev = 0, cus = 0, per_cu = 0;
        hipGetDevice(&dev); hipDeviceGetAttribute(&cus, hipDeviceAttributeMultiprocessorCount, dev);
        if (hipFuncSetAttribute((const void*)fwd_megakernel, hipFuncAttributeMaxDynamicSharedMemorySize, LDS_BYTES) != hipSuccess) { fprintf(stderr, "kernel_launch: hipFuncSetAttribute failed\n"); grid = -1; return; }
        if (hipOccupancyMaxActiveBlocksPerMultiprocessor(&per_cu, (const void*)fwd_megakernel, 512, LDS_BYTES) != hipSuccess || per_cu < 1) { fprintf(stderr, "kernel_launch: occupancy query gave %d\n", per_cu); per_cu = 1; }
        (void)hipGetLastError();
        grid = cus;
    }
    if (grid < 0) return;
    if (hipMemsetAsync((char*)d_ws + WS_CTL, 0, CTL_BYTES, stream) != hipSuccess) { fprintf(stderr, "kernel_launch: memset failed\n"); return; }
    Params p{};
    const float** f = (const float**)&p;
    for (int i = 0; i < 19; ++i) f[i] = (const float*)d_in[i];
    p.out = (float*)d_out; p.ws = (unsigned char*)d_ws;
    void* args[] = {&p};
    const hipError_t e = hipLaunchCooperativeKernel((const void*)fwd_megakernel, dim3(grid), dim3(512), args, LDS_BYTES, stream);
    if (e != hipSuccess) fprintf(stderr, "kernel_launch: cooperative launch failed: %s (grid %d)\n", hipGetErrorString(e), grid);
}
```

```cpp
#include <hip/hip_runtime.h>
#include <hip/hip_cooperative_groups.h>
#include <cstdio>
#include <cstdint>
#include <cmath>
#include <hip/hip_bf16.h>
namespace cg = cooperative_groups;
#ifndef REP_ATT
#define REP_ATT 1
#endif
#ifndef REP_P4
#define REP_P4 1
#endif
#ifndef REP_P1
#define REP_P1 1
#endif
#ifndef REP_P2B
#define REP_P2B 1
#endif
#ifndef REP_P0
#define REP_P0 1
#endif
#ifndef REP_SYNC
#define REP_SYNC 0
#endif
#ifndef REP_SGU
#define REP_SGU 1
#endif
#ifndef FUSE_SGU
#define FUSE_SGU 1
#endif
#ifndef PH
#define PH 63
#endif
namespace pg8 {
#define PG8_LAS __attribute__((address_space(3)))
typedef unsigned short bf16_t;
typedef short bf16x8 __attribute__((ext_vector_type(8)));
typedef float f32x4 __attribute__((ext_vector_type(4)));
typedef unsigned u32x4 __attribute__((ext_vector_type(4)));
constexpr int BM = 256, BK = 64, HALF = 128, HTB = HALF * BK * 2  , STAGE_BYTES = 8 * HTB, NXCD = 8, WGM = 8;

__host__ __device__ __forceinline__ int lds_byte(int r, int c) { const int st = (r >> 4) * 2 + (c >> 5), rr = r & 15, cc = c & 31, ob = rr * 64 + cc * 2; return st * 1024 + (ob ^ (((ob >> 9) & 1) << 5)); }
__host__ __device__ __forceinline__ void stage_rc(int b, int& R, int& C) { const int st = b / 1024, sb = b % 1024, swz = sb ^ (((sb >> 9) & 1) << 5); R = (st >> 1) * 16 + swz / 64; C = (st & 1) * 32 + (swz % 64) / 2; }
__host__ __device__ __forceinline__ int perm32(int rho) { const int n = rho >> 4, i = rho & 15; return 8 * (i >> 2) + 4 * n + (i & 3); }

struct Unit { int pm, pn, ui; };
struct Gemm { const bf16_t* A; const bf16_t* Bt; int M, N, K; int a_tile_rows, a_half_rows, a_skip; };

struct StaticOrder {
    int nM, nN, nwg, G, c;
    __host__ __device__ void init(int M, int N, int G_, int c_) { nM = M / BM; nN = N / BM; nwg = nM * nN; G = G_; c = c_; }
    __host__ __device__ bool next(int i, Unit& u) const {
        const long L = (long)i * G + c; if (L >= nwg) return false;
        int wgid = (int)L; { const int q = nwg / NXCD, r = nwg % NXCD, xcd = wgid % NXCD, off = wgid / NXCD; wgid = (xcd < r ? xcd * (q + 1) : r * (q + 1) + (xcd - r) * q) + off; }
        const int nig = WGM * nN, gid = wgid / nig, fm = gid * WGM, gsz = (nM - fm) < WGM ? (nM - fm) : WGM;
        u.pm = fm + ((wgid % nig) % gsz); u.pn = (wgid % nig) / gsz; u.ui = i; return true;
    }
    __device__ __forceinline__ void a_ready(const Unit&) const {}
    __device__ __forceinline__ void done(const Unit&) const {}
};

__device__ __forceinline__ unsigned cvt_pk_bf16(float lo, float hi) { unsigned r; asm volatile("v_cvt_pk_bf16_f32 %0, %1, %2" : "=v"(r) : "v"(lo), "v"(hi)); return r; }
template <class Epi, class Sched, bool ALIGN_EPI = false, bool SP2 = false>
__device__ __forceinline__ void gemm_phase(PG8_LAS unsigned char* lds, const Gemm g, const Sched& S, const Epi& E) {
    int tid_ = threadIdx.x; asm volatile("" : "+v"(tid_));
    const int tid = tid_, wid = __builtin_amdgcn_readfirstlane(tid >> 6), lane = tid & 63, wr = wid >> 2, wc = wid & 3, fr = lane & 15, fq = lane >> 4;
    const int K = g.K, nt = K / BK;
    unsigned voffA[2], voffB[2];
#pragma unroll
    for (int i = 0; i < 2; ++i) { int R, C; stage_rc(tid * 16 + i * 8192, R, C); const int Rb = Epi::PERM ? ((R & ~31) + perm32(R & 31)) : R;
        voffA[i] = (unsigned)((R - g.a_skip * (R >> 6)) * K + C) * 2u; voffB[i] = (unsigned)(Rb * K + C) * 2u; }
    const size_t kstep = (size_t)(BK * 2);
    const size_t hstepB = (size_t)HALF * K * 2, hstepA = (size_t)g.a_half_rows * K * 2;
    const size_t tstepB = 2 * hstepB, tstepA = (size_t)g.a_tile_rows * K * 2;
    const unsigned ldsw = (unsigned)wid * 1024u;
    const int aoff = lds_byte(wr * 64 + fr, fq * 8), boff = lds_byte(wc * 32 + fr, fq * 8);
#define PG8_SA(b, h) (((b) * 2 + (h)) * HTB)
#define PG8_SB(b, h) ((4 + (b) * 2 + (h)) * HTB)
#define PG8_STAGE(bufoff, gbase, voff) do { _Pragma("unroll") for (int _i = 0; _i < 2; ++_i) \
        __builtin_amdgcn_global_load_lds((const unsigned*)((const char*)(gbase) + (voff)[_i]), (PG8_LAS unsigned*)(lds + (bufoff) + ldsw + _i * 8192), 16, 0, 0); } while (0)
#define PG8_LDA(dst, b, h) do { _Pragma("unroll") for (int m = 0; m < 4; ++m) _Pragma("unroll") for (int k = 0; k < 2; ++k) dst[m][k] = *(const PG8_LAS bf16x8*)(lds + PG8_SA(b, h) + aoff + m * 2048 + k * 1024); } while (0)
#define PG8_LDB(dst, b, h) do { _Pragma("unroll") for (int n = 0; n < 2; ++n) _Pragma("unroll") for (int k = 0; k < 2; ++k) dst[n][k] = *(const PG8_LAS bf16x8*)(lds + PG8_SB(b, h) + boff + n * 2048 + k * 1024); } while (0)
#define PG8_MMA(ai, bj, At, Bt) do { __builtin_amdgcn_s_setprio(1); _Pragma("unroll") for (int m = 0; m < 4; ++m) _Pragma("unroll") for (int n = 0; n < 2; ++n) _Pragma("unroll") for (int k = 0; k < 2; ++k) \
        acc[ai][bj][m][n] = __builtin_amdgcn_mfma_f32_16x16x32_bf16(Bt[n][k], At[m][k], acc[ai][bj][m][n], 0, 0, 0); __builtin_amdgcn_s_setprio(0); } while (0)
#define PG8_WAIT_V(n) asm volatile("s_waitcnt vmcnt(" #n ")" ::: "memory")
#define PG8_WAIT_L(n) asm volatile("s_waitcnt lgkmcnt(" #n ")" ::: "memory")
#define PG8_BAR __builtin_amdgcn_s_barrier()
#define PG8_SCHED __builtin_amdgcn_sched_barrier(0)
    Unit cur, nxt; int ui = 0;
    if (!S.next(0, cur)) return;
    f32x4 acc[2][2][4][2];
#pragma unroll
    for (int a = 0; a < 2; ++a)
#pragma unroll
        for (int b = 0; b < 2; ++b)
#pragma unroll
            for (int m = 0; m < 4; ++m)
#pragma unroll
                for (int n = 0; n < 2; ++n) acc[a][b][m][n] = (f32x4){0.f, 0.f, 0.f, 0.f};
    bf16x8 At[4][2], B0[2][2], B1[2][2];
    const char* cA = (const char*)g.A + (size_t)cur.pm * tstepA; const char* cB = (const char*)g.Bt + (size_t)cur.pn * tstepB;
    S.a_ready(cur);
    if constexpr (SP2) {
        PG8_STAGE(PG8_SB(0, 0), cB, voffB); PG8_STAGE(PG8_SB(0, 1), cB + hstepB, voffB); PG8_STAGE(PG8_SA(0, 0), cA, voffA); PG8_STAGE(PG8_SA(0, 1), cA + hstepA, voffA);
        if (wr == 1) PG8_BAR;
        PG8_WAIT_V(2); PG8_BAR;
        PG8_STAGE(PG8_SB(1, 0), cB + kstep, voffB); PG8_STAGE(PG8_SA(1, 0), cA + kstep, voffA); PG8_STAGE(PG8_SB(1, 1), cB + hstepB + kstep, voffB);
        PG8_WAIT_V(6); PG8_BAR;
    } else {
        PG8_STAGE(PG8_SB(0, 0), cB, voffB); PG8_STAGE(PG8_SA(0, 0), cA, voffA); PG8_STAGE(PG8_SB(0, 1), cB + hstepB, voffB); PG8_STAGE(PG8_SA(0, 1), cA + hstepA, voffA);
        if (wr == 1) PG8_BAR;
        PG8_WAIT_V(4); PG8_BAR;
        PG8_STAGE(PG8_SB(1, 0), cB + kstep, voffB); PG8_STAGE(PG8_SA(1, 0), cA + kstep, voffA); PG8_STAGE(PG8_SB(1, 1), cB + hstepB + kstep, voffB);
        PG8_WAIT_V(6); PG8_BAR;
    }
    for (;;) {
        const bool has_next = S.next(ui + 1, nxt);
        const char* nA = has_next ? (const char*)g.A + (size_t)nxt.pm * tstepA : cA; const char* nB = has_next ? (const char*)g.Bt + (size_t)nxt.pn * tstepB : cB;
        for (int t = 0; t < nt; t += 2) {
            const bool last = (t == nt - 2);
            const char* a1 = cA + (size_t)(t + 1) * kstep;
            const char* a2 = last ? nA : cA + (size_t)(t + 2) * kstep; const char* b2 = last ? nB : cB + (size_t)(t + 2) * kstep;
            const char* a3 = a2 + kstep; const char* b3 = b2 + kstep;
            if (last && has_next) S.a_ready(nxt);
            if constexpr (SP2) {
            PG8_LDB(B0, 0, 0); PG8_LDB(B1, 0, 1); PG8_SCHED; PG8_LDA(At, 0, 0); PG8_STAGE(PG8_SA(1, 1), a1 + hstepA, voffA);
            PG8_WAIT_V(8); PG8_WAIT_L(0); PG8_BAR; PG8_MMA(0, 0, At, B0); PG8_MMA(0, 1, At, B1); PG8_BAR; PG8_SCHED;
            PG8_LDA(At, 0, 1); PG8_STAGE(PG8_SB(0, 0), b2, voffB); PG8_STAGE(PG8_SB(0, 1), b2 + hstepB, voffB); PG8_STAGE(PG8_SA(0, 0), a2, voffA);
            PG8_WAIT_V(8); PG8_WAIT_L(0); PG8_BAR; PG8_MMA(1, 0, At, B0); PG8_MMA(1, 1, At, B1); PG8_BAR; PG8_SCHED;
            PG8_LDB(B0, 1, 0); PG8_LDB(B1, 1, 1); PG8_SCHED; PG8_LDA(At, 1, 0); PG8_STAGE(PG8_SA(0, 1), a2 + hstepA, voffA);
            PG8_WAIT_V(8); PG8_WAIT_L(0); PG8_BAR; PG8_MMA(0, 0, At, B0); PG8_MMA(0, 1, At, B1); PG8_BAR; PG8_SCHED;
            PG8_LDA(At, 1, 1); PG8_STAGE(PG8_SB(1, 0), b3, voffB); PG8_STAGE(PG8_SB(1, 1), b3 + hstepB, voffB); PG8_STAGE(PG8_SA(1, 0), a3, voffA);
            PG8_WAIT_V(8); PG8_WAIT_L(0); PG8_BAR; PG8_MMA(1, 0, At, B0); PG8_MMA(1, 1, At, B1); PG8_BAR; PG8_SCHED;
            } else {
            PG8_LDB(B0, 0, 0); PG8_SCHED; PG8_LDA(At, 0, 0); PG8_STAGE(PG8_SA(1, 1), a1 + hstepA, voffA);
            PG8_WAIT_L(8); PG8_BAR; PG8_WAIT_L(0); PG8_MMA(0, 0, At, B0); PG8_BAR; PG8_SCHED;
            PG8_LDB(B1, 0, 1); PG8_STAGE(PG8_SB(0, 0), b2, voffB);
            PG8_BAR; PG8_WAIT_L(0); PG8_MMA(0, 1, At, B1); PG8_BAR;
            PG8_LDA(At, 0, 1); PG8_STAGE(PG8_SA(0, 0), a2, voffA);
            PG8_BAR; PG8_WAIT_L(0); PG8_MMA(1, 0, At, B0); PG8_BAR; PG8_SCHED;
            PG8_STAGE(PG8_SB(0, 1), b2 + hstepB, voffB);
            PG8_WAIT_V(6); PG8_BAR; PG8_MMA(1, 1, At, B1); PG8_BAR;
            PG8_LDB(B0, 1, 0); PG8_SCHED; PG8_LDA(At, 1, 0); PG8_STAGE(PG8_SA(0, 1), a2 + hstepA, voffA);
            PG8_WAIT_L(8); PG8_BAR; PG8_WAIT_L(0); PG8_MMA(0, 0, At, B0); PG8_BAR; PG8_SCHED;
            PG8_LDB(B1, 1, 1); PG8_STAGE(PG8_SB(1, 0), b3, voffB);
            PG8_BAR; PG8_WAIT_L(0); PG8_MMA(0, 1, At, B1); PG8_BAR;
            PG8_LDA(At, 1, 1); PG8_STAGE(PG8_SA(1, 0), a3, voffA);
            PG8_BAR; PG8_WAIT_L(0); PG8_MMA(1, 0, At, B0); PG8_BAR; PG8_SCHED;
            PG8_STAGE(PG8_SB(1, 1), b3 + hstepB, voffB);
            PG8_WAIT_V(6); PG8_BAR; PG8_MMA(1, 1, At, B1); PG8_BAR;
            }
        }
        if constexpr (ALIGN_EPI) { if (wr == 0) PG8_BAR; }
        if constexpr (!Epi::AFTER_DRAIN) { E(acc, cur, wr, wc, fr, fq); S.done(cur); }
        if (!has_next) break;
#pragma unroll
        for (int a = 0; a < 2; ++a)
#pragma unroll
            for (int b = 0; b < 2; ++b)
#pragma unroll
                for (int m = 0; m < 4; ++m)
#pragma unroll
                    for (int n = 0; n < 2; ++n) acc[a][b][m][n] = (f32x4){0.f, 0.f, 0.f, 0.f};
        cur = nxt; cA = nA; cB = nB; ++ui;
        if constexpr (ALIGN_EPI) { if (wr == 1) PG8_BAR; }
    }
    PG8_WAIT_V(0);
    if constexpr (!ALIGN_EPI) { if (wr == 0) PG8_BAR; }
    PG8_BAR;
    if constexpr (Epi::AFTER_DRAIN) { E.fused(acc, cur, wr, wc, fr, fq, lds, wid, lane); S.done(cur); }
#undef PG8_SA
#undef PG8_SB
#undef PG8_STAGE
#undef PG8_LDA
#undef PG8_LDB
#undef PG8_MMA
#undef PG8_WAIT_V
#undef PG8_WAIT_L
#undef PG8_BAR
#undef PG8_SCHED
}
}
using pg8::bf16_t; using pg8::bf16x8; using pg8::f32x4; using pg8::u32x4;
#define LAS __attribute__((address_space(3)))
typedef float f32x16 __attribute__((ext_vector_type(16)));
typedef float f32x2 __attribute__((ext_vector_type(2)));
typedef unsigned u32x2 __attribute__((ext_vector_type(2)));
typedef short s16x4 __attribute__((ext_vector_type(4)));

constexpr int SEQ = 8192, NB = 2, M = NB * SEQ, D = 1024, DIN = 2560, DFF = 2816, NUP = 2 * DFF, DEPTH = 2;
constexpr int NH = 4, HD = 64, VD = 128;
constexpr float NORM_EPS = 1e-6f, SUBLN_EPS = 1e-5f, LN_EPS = 1e-5f;
constexpr float LOG2E = 1.4426950408889634f;
constexpr float QSCALE = 0.125f * LOG2E;
constexpr int P4_ROWS = 248, P4_TILES = (M + P4_ROWS - 1) / P4_ROWS;

constexpr size_t MiB = 1u << 20;
constexpr size_t WS_SS = 0;
constexpr size_t WS_W = 1 * MiB;
constexpr size_t W_IN = 0, W_OUT = 5 * MiB, W_UP = 7 * MiB, W_DOWN = 18 * MiB, W_LAYER = 47 * MiB / 2;
constexpr size_t WS_XB = 48 * MiB;
constexpr size_t WS_Z = 80 * MiB;
constexpr size_t WS_MIX = 160 * MiB;
constexpr size_t WS_Y = 80 * MiB;
constexpr size_t WS_OP1 = 192 * MiB;
constexpr size_t WS_CTL = 224 * MiB, CTL_BYTES = 131072;
constexpr size_t WS_END = 225 * MiB;
static_assert(WS_W + 2 * W_LAYER <= WS_XB && WS_Y + (size_t)M * DFF * 2 <= WS_OP1 && WS_MIX + (size_t)M * D * 2 <= WS_OP1, "ws map");

constexpr int RING_BYTES = 131072, LDS_BYTES = 147456;

__device__ __forceinline__ unsigned f2bf(float f) { unsigned u = __builtin_bit_cast(unsigned, f); return (u + 0x7fffu + ((u >> 16) & 1u)) >> 16; }
__device__ __forceinline__ unsigned pk2(float lo, float hi) { return f2bf(lo) | (f2bf(hi) << 16); }
__device__ __forceinline__ unsigned cvtpk(float lo, float hi) { return pg8::cvt_pk_bf16(lo, hi); }
__device__ __forceinline__ float bf2f(unsigned short b) { return __builtin_bit_cast(float, (unsigned)b << 16); }
__device__ __forceinline__ float bflo(unsigned w) { return __builtin_bit_cast(float, w << 16); }
__device__ __forceinline__ float bfhi(unsigned w) { return __builtin_bit_cast(float, w & 0xffff0000u); }
__device__ __forceinline__ float shx(float v, int mask, int lane) { return __builtin_bit_cast(float, __builtin_amdgcn_ds_bpermute((lane ^ mask) << 2, __builtin_bit_cast(int, v))); }
__device__ __forceinline__ float wave_sum(float v, int lane) {
#pragma unroll
    for (int o = 1; o < 64; o <<= 1) v += shx(v, o, lane);
    return v;
}
__device__ __forceinline__ float gelu_t(float x) {
    const float u = x * (1.0f + 0.044715f * x * x);
    const float e = __builtin_amdgcn_exp2f(-2.302208198f * u);
    return x * __builtin_amdgcn_rcpf(1.0f + e);
}
__device__ __forceinline__ f32x2 gelu_t2(f32x2 x) {
    f32x2 t = x * x; t = t * 0.044715f + 1.0f; const f32x2 u = (x * t) * (-2.302208198f);
    f32x2 e; e.x = __builtin_amdgcn_exp2f(u.x); e.y = __builtin_amdgcn_exp2f(u.y); e = e + 1.0f;
    f32x2 r; r.x = __builtin_amdgcn_rcpf(e.x); r.y = __builtin_amdgcn_rcpf(e.y);
    return x * r;
}
__device__ __forceinline__ float row_rstd(const float* ss, int row, float eps) {
    const f32x4* p = (const f32x4*)(ss + (size_t)row * 16);
    const f32x4 a = p[0], b = p[1], c = p[2], d = p[3];
    const float s = (((a[0] + a[1]) + (a[2] + a[3])) + ((b[0] + b[1]) + (b[2] + b[3]))) + (((c[0] + c[1]) + (c[2] + c[3])) + ((d[0] + d[1]) + (d[2] + d[3])));
    return __builtin_amdgcn_rsqf(s * (1.0f / D) + eps);
}
constexpr int RSTAB_OFF = RING_BYTES;
template <bool P4MAP, class Sched> __device__ __forceinline__ void fill_rstd(LAS unsigned char* lds, const Sched& S, const float* ss) {
    int t = threadIdx.x; asm volatile("" : "+v"(t));
    LAS float* tab = (LAS float*)(lds + RSTAB_OFF); pg8::Unit u;
    const int r = t & 255, h = t >> 8;
#pragma unroll
    for (int k = 0; k < 4; ++k) { const int i = 2 * k + h;
        if (S.next(i, u)) {
            int tok = P4MAP ? u.pm * P4_ROWS + 62 * (r >> 6) + (r & 63) - 2 : u.pm * 256 + r; tok = tok < 0 ? 0 : (tok > M - 1 ? M - 1 : tok);
            tab[i * 256 + r] = row_rstd(ss, tok, NORM_EPS); } }
    __syncthreads();
}

struct EpiInProj {
    static constexpr bool PERM = true, AFTER_DRAIN = false;
    bf16_t* Z; LAS const float* tab; bool wt;
    __device__ __forceinline__ void operator()(f32x4 (&acc)[2][2][4][2], const pg8::Unit& u, int wr, int wc, int fr, int fq) const {
        asm volatile("" : "+v"(fr), "+v"(fq));
        const __amdgpu_buffer_rsrc_t zr = __builtin_amdgcn_make_buffer_rsrc((void*)Z, 0, M * DIN * 2, 0x00020000);
        const int row0 = u.pm * 256 + wr * 64 + fr, col0 = u.pn * 256 + wc * 32 + 8 * fq;
#pragma unroll
        for (int ai = 0; ai < 2; ++ai)
#pragma unroll
            for (int m = 0; m < 4; ++m) {
                const int row = row0 + ai * 128 + m * 16; const float rs = tab[u.ui * 256 + ai * 128 + wr * 64 + m * 16 + fr];
                bf16_t* rowp = Z + (size_t)row * DIN + col0;
#pragma unroll
                for (int bj = 0; bj < 2; ++bj) { const f32x4 v0 = acc[ai][bj][m][0] * rs, v1 = acc[ai][bj][m][1] * rs;
                    u32x4 w; w.x = cvtpk(v0[0], v0[1]); w.y = cvtpk(v0[2], v0[3]); w.z = cvtpk(v1[0], v1[1]); w.w = cvtpk(v1[2], v1[3]);
                    if (wt && u.ui == 0) __builtin_amdgcn_raw_buffer_store_b128(w, zr, (unsigned)(((size_t)row * DIN + col0 + bj * 128) * 2), 0,   16);
                    else *(u32x4*)(rowp + bj * 128) = w; }
            }
    }
};
struct InProjOrder {
    pg8::StaticOrder A, B; unsigned* cnt; bool pub;
    __device__ void init(int G_, int c_, unsigned* cnt_, bool pub_) { A.init(M, 1024, G_, c_); B.init(M, 1536, G_, c_); cnt = cnt_; pub = pub_; }
    __device__ bool next(int i, pg8::Unit& u) const { if (i == 0) { const bool ok = A.next(0, u); u.pn += 6; u.ui = 0; return ok; } const bool ok = B.next(i - 1, u); u.ui = i; return ok; }
    __device__ __forceinline__ void a_ready(const pg8::Unit&) const {}
    __device__ __forceinline__ void done(const pg8::Unit& u) const {
        if (pub && u.ui == 0) { asm volatile("s_waitcnt vmcnt(0)" ::: "memory"); __builtin_amdgcn_s_barrier(); asm volatile("" ::: "memory");
            if (threadIdx.x == 0) __hip_atomic_fetch_add(cnt, 1u, __ATOMIC_RELAXED, __HIP_MEMORY_SCOPE_AGENT); }
    }
};
struct EpiRes {
    static constexpr bool PERM = true, AFTER_DRAIN = false;
    const float* resf; bf16_t* xb; float* ss;
    __device__ __forceinline__ void operator()(f32x4 (&acc)[2][2][4][2], const pg8::Unit& u, int wr, int wc, int fr, int fq) const {
        asm volatile("" : "+v"(fr), "+v"(fq));
        const int col0 = u.pn * 256 + wc * 32 + 8 * fq;
#pragma unroll
        for (int ai = 0; ai < 2; ++ai)
#pragma unroll
            for (int m = 0; m < 4; ++m) {
                const int row = u.pm * 256 + ai * 128 + wr * 64 + m * 16 + fr; float sq = 0.f;
#pragma unroll
                for (int bj = 0; bj < 2; ++bj) { const size_t off = (size_t)row * D + col0 + bj * 128;
                    f32x4 r0, r1;
                    if (resf) { r0 = *(const f32x4*)(resf + off); r1 = *(const f32x4*)(resf + off + 4); }
                    else { const u32x4 w = *(const u32x4*)(xb + off); r0 = (f32x4){bflo(w.x), bfhi(w.x), bflo(w.y), bfhi(w.y)}; r1 = (f32x4){bflo(w.z), bfhi(w.z), bflo(w.w), bfhi(w.w)}; }
                    const f32x4 o0 = r0 + acc[ai][bj][m][0], o1 = r1 + acc[ai][bj][m][1];
                    sq += ((o0[0] * o0[0] + o0[1] * o0[1]) + (o0[2] * o0[2] + o0[3] * o0[3])) + ((o1[0] * o1[0] + o1[1] * o1[1]) + (o1[2] * o1[2] + o1[3] * o1[3]));
                    u32x4 w; w.x = cvtpk(o0[0], o0[1]); w.y = cvtpk(o0[2], o0[3]); w.z = cvtpk(o1[0], o1[1]); w.w = cvtpk(o1[2], o1[3]);
                    *(u32x4*)(xb + off) = w; }
                { const int ln_ = fq * 16 + fr; sq += shx(sq, 16, ln_); sq += shx(sq, 32, ln_); }
                if (fq == 0) ss[(size_t)row * 16 + u.pn * 4 + wc] = sq;
            }
    }
};
struct EpiResFinal {
    static constexpr bool PERM = true, AFTER_DRAIN = false;
    const bf16_t* xb; float* ss; float* out; const float* fg; unsigned* cnt; LAS float* tab;
    __device__ __forceinline__ void operator()(f32x4 (&acc)[2][2][4][2], const pg8::Unit& u, int wr, int wc, int fr, int fq) const {
        asm volatile("" : "+v"(fr), "+v"(fq));
        const int col0 = u.pn * 256 + wc * 32 + 8 * fq;
#pragma unroll
        for (int ai = 0; ai < 2; ++ai)
#pragma unroll
            for (int m = 0; m < 4; ++m) {
                const int row = u.pm * 256 + ai * 128 + wr * 64 + m * 16 + fr; float sq = 0.f;
#pragma unroll
                for (int bj = 0; bj < 2; ++bj) { const size_t off = (size_t)row * D + col0 + bj * 128;
                    const u32x4 w = *(const u32x4*)(xb + off);
                    const f32x4 o0 = (f32x4){bflo(w.x), bfhi(w.x), bflo(w.y), bfhi(w.y)} + acc[ai][bj][m][0], o1 = (f32x4){bflo(w.z), bfhi(w.z), bflo(w.w), bfhi(w.w)} + acc[ai][bj][m][1];
                    sq += ((o0[0] * o0[0] + o0[1] * o0[1]) + (o0[2] * o0[2] + o0[3] * o0[3])) + ((o1[0] * o1[0] + o1[1] * o1[1]) + (o1[2] * o1[2] + o1[3] * o1[3]));
                    acc[ai][bj][m][0] = o0; acc[ai][bj][m][1] = o1; }
                { const int ln_ = fq * 16 + fr; sq += shx(sq, 16, ln_); sq += shx(sq, 32, ln_); }
                if (fq == 0) __hip_atomic_store(ss + (size_t)row * 16 + u.pn * 4 + wc, sq, __ATOMIC_RELAXED, __HIP_MEMORY_SCOPE_AGENT);
            }
        asm volatile("s_waitcnt vmcnt(0)" ::: "memory"); __builtin_amdgcn_s_barrier(); asm volatile("" ::: "memory");
        int t = threadIdx.x; asm volatile("" : "+v"(t));
        if (t == 0) { unsigned* c = cnt + 64 * u.pm; __hip_atomic_fetch_add(c, 1u, __ATOMIC_RELAXED, __HIP_MEMORY_SCOPE_AGENT);
            unsigned sp = 0; while (__hip_atomic_load(c, __ATOMIC_RELAXED, __HIP_MEMORY_SCOPE_AGENT) < 4u) { __builtin_amdgcn_s_sleep(1); if (++sp > (1u << 22)) break; }
            __builtin_amdgcn_fence(__ATOMIC_ACQUIRE, "agent"); asm volatile("s_waitcnt vmcnt(0)" ::: "memory"); }
        __builtin_amdgcn_s_barrier(); asm volatile("" ::: "memory");
        if (t < 256) tab[t] = row_rstd(ss, u.pm * 256 + t, NORM_EPS);
        asm volatile("s_waitcnt lgkmcnt(0)" ::: "memory"); __builtin_amdgcn_s_barrier(); asm volatile("" ::: "memory");
        f32x4 g0[2], g1[2];
#pragma unroll
        for (int bj = 0; bj < 2; ++bj) { g0[bj] = *(const f32x4*)(fg + col0 + bj * 128); g1[bj] = *(const f32x4*)(fg + col0 + bj * 128 + 4); }
#pragma unroll
        for (int ai = 0; ai < 2; ++ai)
#pragma unroll
            for (int m = 0; m < 4; ++m) {
                const int lr = ai * 128 + wr * 64 + m * 16 + fr; const float rs = tab[lr]; float* op = out + (size_t)(u.pm * 256 + lr) * D + col0;
#pragma unroll
                for (int bj = 0; bj < 2; ++bj) { __builtin_nontemporal_store(acc[ai][bj][m][0] * rs * g0[bj], (f32x4*)(op + bj * 128)); __builtin_nontemporal_store(acc[ai][bj][m][1] * rs * g1[bj], (f32x4*)(op + bj * 128 + 4)); }
            }
    }
};
template <int CTRL> __device__ __forceinline__ float dppf(float old, float src) {
    return __builtin_bit_cast(float, __builtin_amdgcn_update_dpp(__builtin_bit_cast(int, old), __builtin_bit_cast(int, src), CTRL, 0xf, 0xf, false)); }
template <int CTRL> __device__ __forceinline__ float dppz(float src) {
    return __builtin_bit_cast(float, __builtin_amdgcn_mov_dpp(__builtin_bit_cast(int, src), CTRL, 0xf, 0xf, true)); }
struct EpiConvGate {
    static constexpr bool PERM = true, AFTER_DRAIN = false;
    bf16_t* Y; LAS const float* tab; const float* cw; const float* cb;
    template <bool MASK> __device__ __forceinline__ void run(f32x4 (&acc)[2][2][4][2], const pg8::Unit& u, int wr, int wc, int fr, int fq) const {
        const int ch0 = u.pn * 128 + wc * 32 + 8 * fq;
        u32x2 park[2][4];
#pragma unroll
        for (int n = 0; n < 2; ++n) {
            asm volatile("" ::: "memory");
            const int ch = ch0 + 4 * n;
            f32x4 w0[2], w1[2], w2[2], bb[2];
#pragma unroll
            for (int bj = 0; bj < 2; ++bj) { const int col = bj * DFF + ch;
                w0[bj] = *(const f32x4*)(cw + col); w1[bj] = *(const f32x4*)(cw + NUP + col); w2[bj] = *(const f32x4*)(cw + 2 * NUP + col); bb[bj] = *(const f32x4*)(cb + col); }
#pragma unroll
            for (int ai = 0; ai < 2; ++ai)
#pragma unroll
                for (int m = 0; m < 4; ++m) {
                    const int tok = u.pm * P4_ROWS + 62 * (2 * ai + wr) + 16 * m + fr - 2; const int tpos = tok & (SEQ - 1);
                    f32x4 o[2];
#pragma unroll
                    for (int bj = 0; bj < 2; ++bj) {
                        const f32x4 cur = acc[ai][bj][m][n]; const f32x4 prv = acc[ai][bj][m > 0 ? m - 1 : 0][n];
                        f32x4 p1, p2;
#pragma unroll
                        for (int i = 0; i < 4; ++i) {
                            p1[i] = dppf<0x111>(dppz<0x10f>(prv[i]), cur[i]);
                            p2[i] = dppf<0x112>(dppz<0x10e>(prv[i]), cur[i]);
                            if (MASK) { p1[i] = tpos >= 1 ? p1[i] : 0.f; p2[i] = tpos >= 2 ? p2[i] : 0.f; }
                        }
                        o[bj] = bb[bj] + w2[bj] * cur + w1[bj] * p1 + w0[bj] * p2;
                    }
                    const f32x2 ga = gelu_t2((f32x2){o[0][0], o[0][1]}) * (f32x2){o[1][0], o[1][1]}, gb = gelu_t2((f32x2){o[0][2], o[0][3]}) * (f32x2){o[1][2], o[1][3]};
                    u32x2 w; w.x = cvtpk(ga.x, ga.y); w.y = cvtpk(gb.x, gb.y);
                    if (n == 0) park[ai][m] = w;
                    else if ((m > 0 || fr >= 2) && tok < M) { u32x4 w4; w4.x = park[ai][m].x; w4.y = park[ai][m].y; w4.z = w.x; w4.w = w.y; *(u32x4*)(Y + (size_t)tok * DFF + ch0) = w4; }
                }
        }
    }
    __device__ __forceinline__ void operator()(f32x4 (&acc)[2][2][4][2], const pg8::Unit& u, int wr, int wc, int fr, int fq) const {
        asm volatile("" : "+v"(fr), "+v"(fq));
#pragma unroll
        for (int ai = 0; ai < 2; ++ai)
#pragma unroll
            for (int m = 0; m < 4; ++m) {
                const float rs = tab[u.ui * 256 + ai * 128 + wr * 64 + m * 16 + fr];
#pragma unroll
                for (int bj = 0; bj < 2; ++bj)
#pragma unroll
                    for (int n = 0; n < 2; ++n) acc[ai][bj][m][n] *= rs;
            }
        const int t0 = u.pm * P4_ROWS - 2;
        if (((t0 + 255) >> 13) != ((t0 - 2) >> 13)) run<true>(acc, u, wr, wc, fr, fq); else run<false>(acc, u, wr, wc, fr, fq);
    }
};
namespace attn_body {
using bf16=__hip_bfloat16;
using bf16x8=__attribute__((ext_vector_type(8)))short;
using s16x4=__attribute__((ext_vector_type(4)))short;
using f32x16=__attribute__((ext_vector_type(16)))float;
using u32x4=__attribute__((ext_vector_type(4)))unsigned;
constexpr int SEQ=8192,D=64,ZP=2560,OP=512;
constexpr int NW=8,QBLK=32,QB=QBLK*NW,KVBLK=64,NQB=SEQ/QB;
constexpr int ATTN_UNIT_ROWS=QB;
__device__ __forceinline__ int crow(int r,int hi){return (r&3)+8*(r>>2)+4*hi;}
#define SBAR() __builtin_amdgcn_sched_barrier(0)
__device__ __forceinline__ void cmask(f32x16&p0,f32x16&p1,int jb,int qrel,int hi){
  const float NEG=-INFINITY; int kb=64*jb+4*hi;
  #pragma unroll
  for(int r=0;r<16;++r){int kv=kb+(r&3)+8*(r>>2); if(kv>qrel)p0[r]=NEG; if(kv+32>qrel)p1[r]=NEG;}
}

constexpr int NSLOT=3, SLOTB=8192;
constexpr int LDS_K=0, LDS_V=NSLOT*SLOTB, LDS_WS=LDS_V+NSLOT*2*SLOTB, LDS_OST=LDS_WS+NW*64*4, LDS_BYTES=LDS_OST+NW*8192;
constexpr float C2=0.125f*1.4426950408889634f;
__device__ __forceinline__ void glds16(const void*gsrc,unsigned lds_dst){unsigned keep;
  asm volatile("s_mov_b32 %0, m0\n\ts_mov_b32 m0, %2\n\ts_nop 0\n\tglobal_load_lds_dwordx4 %1, off\n\ts_mov_b32 m0, %0":"=&s"(keep):"v"(gsrc),"s"(lds_dst):"memory");}
__device__ __forceinline__ float max3f(float a,float b,float c){float r;asm("v_max3_f32 %0, %1, %2, %3":"=v"(r):"v"(a),"v"(b),"v"(c));return r;}
__device__ __forceinline__ float max2f(float a,float b){float r;asm("v_max_f32_e32 %0, %1, %2":"=v"(r):"v"(a),"v"(b));return r;}
__device__ __forceinline__ float fadd_s(float a,float b){float r;asm("v_add_f32_e32 %0, %1, %2":"=v"(r):"v"(a),"v"(b));return r;}
__device__ __forceinline__ float fsub_s(float a,float b){float r;asm("v_sub_f32_e32 %0, %1, %2":"=v"(r):"v"(a),"v"(b));return r;}
typedef float f32x2_t __attribute__((ext_vector_type(2))); typedef float f32x4_t __attribute__((ext_vector_type(4))); typedef __bf16 bf16x2_t __attribute__((ext_vector_type(2)));
__device__ __forceinline__ unsigned cvtpk_s(float lo,float hi){f32x2_t v={lo,hi};bf16x2_t b=__builtin_convertvector(v,bf16x2_t);return __builtin_bit_cast(unsigned,b);}
__device__ __forceinline__ float bfr(float x){unsigned u=__float_as_uint(x);u=(u+0x7fffu+((u>>16)&1u))&0xffff0000u;return __uint_as_float(u);}
#define WAIT_BAR(N) asm volatile("s_waitcnt vmcnt(" #N ") lgkmcnt(0)\n\ts_barrier":::"memory")

__device__ __forceinline__ void qkt(f32x16&p0,f32x16&p1,const char*Kslot,const bf16x8*qr,const f32x16&c0,const f32x16&c1,int r32,int hi){
  const char*kb=Kslot+hi*1024+r32*16;
  #pragma unroll
  for(int d0=0;d0<4;++d0){
    const bf16x8 b0=*reinterpret_cast<const bf16x8*>(kb+d0*2048);
    const bf16x8 b1=*reinterpret_cast<const bf16x8*>(kb+d0*2048+512);
    if(d0==0){p0=__builtin_amdgcn_mfma_f32_32x32x16_bf16(b0,qr[0],c0,0,0,0);p1=__builtin_amdgcn_mfma_f32_32x32x16_bf16(b1,qr[0],c1,0,0,0);}
    else{p0=__builtin_amdgcn_mfma_f32_32x32x16_bf16(b0,qr[d0],p0,0,0,0);p1=__builtin_amdgcn_mfma_f32_32x32x16_bf16(b1,qr[d0],p1,0,0,0);}}
}
typedef __attribute__((address_space(3))) const char* lds_cptr;
typedef short v4i16_t __attribute__((ext_vector_type(4)));
__device__ __forceinline__ void kload8(bf16x8*kf,lds_cptr kp){
  kf[0]=*(const __attribute__((address_space(3))) bf16x8*)(kp);      kf[1]=*(const __attribute__((address_space(3))) bf16x8*)(kp+512);
  kf[2]=*(const __attribute__((address_space(3))) bf16x8*)(kp+2048); kf[3]=*(const __attribute__((address_space(3))) bf16x8*)(kp+2560);
  kf[4]=*(const __attribute__((address_space(3))) bf16x8*)(kp+4096); kf[5]=*(const __attribute__((address_space(3))) bf16x8*)(kp+4608);
  kf[6]=*(const __attribute__((address_space(3))) bf16x8*)(kp+6144); kf[7]=*(const __attribute__((address_space(3))) bf16x8*)(kp+6656);
}
__device__ __forceinline__ void kload2(bf16x8*kf,lds_cptr kp,int j){ kf[2*j]=*(const __attribute__((address_space(3))) bf16x8*)(kp+j*2048); kf[2*j+1]=*(const __attribute__((address_space(3))) bf16x8*)(kp+j*2048+512); }
__device__ __forceinline__ s16x4 vtr(lds_cptr p){ return __builtin_bit_cast(s16x4,__builtin_amdgcn_ds_read_tr16_b64_v4i16((__attribute__((address_space(3))) v4i16_t*)p)); }
__device__ __forceinline__ float rowmax(const f32x16&p0,const f32x16&p1){
  float a=max3f(p0[0],p0[1],p1[0]),b=max3f(p0[2],p0[3],p1[1]);a=max3f(a,p1[2],p1[3]);
  #pragma unroll
  for(int r=4;r<16;r+=4){a=max3f(a,p0[r],p0[r+1]);b=max3f(b,p0[r+2],p0[r+3]);a=max3f(a,p1[r],p1[r+1]);b=max3f(b,p1[r+2],p1[r+3]);}
  const float m=max2f(a,b);
  auto rr=__builtin_amdgcn_permlane32_swap(__float_as_uint(m),__float_as_uint(m),false,false);
  return max2f(__uint_as_float(rr[0]),__uint_as_float(rr[1]));
}
__device__ __forceinline__ void pv(f32x16*o,int vb,bf16x8 pa0,bf16x8 pa1,bf16x8 pa2,bf16x8 pa3){
  #pragma unroll
  for(int d0=0;d0<4;++d0){s16x4 lo[4],hi[4];
    #pragma unroll
    for(int ks=0;ks<4;++ks){
      asm volatile("ds_read_b64_tr_b16 %0,%1 offset:%c2":"=&v"(lo[ks]):"v"(vb),"i"(d0*4096+ks*1024):"memory");
      asm volatile("ds_read_b64_tr_b16 %0,%1 offset:%c2":"=&v"(hi[ks]):"v"(vb),"i"(d0*4096+ks*1024+512):"memory");}
    asm volatile("s_waitcnt lgkmcnt(0)":::"memory");SBAR();
    #define PK(k) (bf16x8){lo[k][0],lo[k][1],lo[k][2],lo[k][3],hi[k][0],hi[k][1],hi[k][2],hi[k][3]}
    o[d0]=__builtin_amdgcn_mfma_f32_32x32x16_bf16(pa0,PK(0),o[d0],0,0,0);
    o[d0]=__builtin_amdgcn_mfma_f32_32x32x16_bf16(pa1,PK(1),o[d0],0,0,0);
    o[d0]=__builtin_amdgcn_mfma_f32_32x32x16_bf16(pa2,PK(2),o[d0],0,0,0);
    o[d0]=__builtin_amdgcn_mfma_f32_32x32x16_bf16(pa3,PK(3),o[d0],0,0,0);
    #undef PK
  }
}

#ifndef ATTN_STORE16
#define ATTN_STORE16(p,v) (*(u32x4*)(p)=(v))
#endif
template<int THRL> __device__ __forceinline__ void attn_unit(int b,int qb,const bf16*Q,const bf16*__restrict__ K,const bf16*__restrict__ V,bf16*O,char*shm,float slope2,const int F_fmode,unsigned*F_flag,unsigned short*F_mixo,const float F_lam,const float F_gscale,const float*F_sg){
  int tid_=threadIdx.x; asm volatile("":"+v"(tid_));
  const int tid=tid_,lane=tid&63,r32=lane&31,hi=lane>>5; const int wid=__builtin_amdgcn_readfirstlane(tid>>6);
  const long rowbase=(long)b*SEQ; const int q0=qb*QB;
  const bf16*Qw=Q+(rowbase+q0+wid*QBLK)*ZP;
  const bf16*Kh=K+rowbase*ZP,*Vh=V+rowbase*ZP;
  const unsigned lds0=(unsigned)(uintptr_t)shm;
  float*wsf=(float*)(shm+LDS_WS)+wid*64;
  const bf16*ksrc=Kh+(long)lane*ZP+wid*8;
  const bf16*vsrc=Vh+(long)(16*(wid&3)+(lane>>2))*ZP+(wid>>2)*32+(lane&3)*8;
  const unsigned kdst=lds0+LDS_K+wid*1024, vdst=lds0+LDS_V+wid*1024;
  #define DMA_K(t,slot) glds16(ksrc+(long)(t)*KVBLK*ZP,(unsigned)__builtin_amdgcn_readfirstlane(kdst+(slot)))
  #define DMA_V(t,slot) do{ glds16(vsrc+(long)(t)*KVBLK*ZP,(unsigned)__builtin_amdgcn_readfirstlane(vdst+2*(slot))); glds16(vsrc+64+(long)(t)*KVBLK*ZP,(unsigned)__builtin_amdgcn_readfirstlane(vdst+8192+2*(slot))); }while(0)
  const int vb0=(int)(lds0+LDS_V)+((lane>>4)&1)*32+(lane&3)*8+(4*hi+((lane&15)>>2))*64;
  const char*Kbase=shm+LDS_K; bf16x8 kf[8];
  const lds_cptr shm3=(lds_cptr)shm; const lds_cptr kp0=shm3+LDS_K+hi*1024+r32*16; const lds_cptr vp0=shm3+LDS_V+((lane>>4)&1)*32+(lane&3)*8+(4*hi+((lane&15)>>2))*64;
  const int NT=(q0+QB)/KVBLK;
  bf16x8 qbf; unsigned locA,locB; constexpr unsigned kbA0=0u,kbB0=0u;
  { float sl_=slope2; asm volatile("":"+v"(sl_));
    const float a1=bfr(sl_), r1=sl_-a1, a2=bfr(r1), a3=bfr(r1-a2);
    const unsigned A1=__float_as_uint(a1)>>16,A2=__float_as_uint(a2)>>16,A3=__float_as_uint(a3)>>16,B1=__float_as_uint(64.f*a1)>>16,B2=__float_as_uint(64.f*a2)>>16,B3=__float_as_uint(64.f*a3)>>16;
    const u32x4 w=hi?(u32x4){0u,0u,0u,0u}:(u32x4){A1|(A2<<16),A3|(B1<<16),B2|(B3<<16),0u}; qbf=__builtin_bit_cast(bf16x8,w);
    locA=hi?0u:(__float_as_uint((float)r32)>>16); locB=hi?0u:(__float_as_uint((float)(r32+32))>>16); }
  const unsigned one2=hi?0u:0x3f803f80u;
  #define SETM() do{ const float mh_=bfr(mhat), ml_=mhat-mh_; u32x4 w_=__builtin_bit_cast(u32x4,qbf); w_.w=hi?0u:((__float_as_uint(-mh_)>>16)|(__float_as_uint(-ml_)&0xffff0000u)); qbf=__builtin_bit_cast(bf16x8,w_); }while(0)
  #define TRB(t) (hi?0u:(__float_as_uint((float)((t)-(NT-4)))>>16))
  #define KBIAS(t,W0,LOC,TB) ({ unsigned l_=(LOC); asm volatile("":"+v"(l_)); __builtin_bit_cast(bf16x8,(u32x4){l_|(l_<<16),l_|((TB)<<16),(TB)|((TB)<<16),one2}); })
  #define BIASC(t,W0,LOC,TB) __builtin_amdgcn_mfma_f32_32x32x16_bf16(KBIAS(t,W0,LOC,TB),qbf,f32x16{},0,0,0)
  DMA_K(0,0);DMA_V(0,0);DMA_K(1,SLOTB);
  bf16x8 qr[4];
  #pragma unroll
  for(int d0=0;d0<4;++d0)qr[d0]=*reinterpret_cast<const bf16x8*>(&Qw[(long)r32*ZP+d0*16+hi*8]);
  const int qrel=wid*QBLK+r32;
  float mhat=__builtin_ceilf(slope2*(float)(qrel+1))+16.f,l_reg=0.f;f32x16 o[4];o[0]=f32x16{};o[1]=f32x16{};o[2]=f32x16{};o[3]=f32x16{}; SETM();
  #define CMASK(P0,P1,t) do{int jb_=(t)-(NT-4); if(jb_>=0)cmask(P0,P1,jb_,qrel,hi);}while(0)
  bool resc=false;
  #define START(P0,P1) do{ const float rm=rowmax(P0,P1); resc=false; \
    { const float dl=__builtin_ceilf(__builtin_fmaxf(rm,0.f)); mhat=fadd_s(mhat,dl); \
      _Pragma("unroll") for(int r=0;r<16;++r){P0[r]=fsub_s(P0[r],dl);P1[r]=fsub_s(P1[r],dl);} \
      SETM(); } \
    _Pragma("unroll") for(int r=0;r<16;++r)P0[r]=__builtin_amdgcn_exp2f(P0[r]); }while(0)
  #define RESC() do{ if(resc){ asm volatile("s_waitcnt lgkmcnt(0)":::"memory"); \
      _Pragma("unroll") for(int d_=0;d_<4;++d_) _Pragma("unroll") for(int r=0;r<16;++r)o[d_][r]*=wsf[crow(r,hi)]; } }while(0)
  f32x16 pA0,pA1,pB0,pB1;
  int sl_prev=0,sl_cur=0,sl_next=SLOTB;
  #define ROT() do{sl_prev=sl_cur;sl_cur=sl_next;sl_next=(sl_next==(NSLOT-1)*SLOTB)?0:sl_next+SLOTB;}while(0)
  DMA_K(2,2*SLOTB);
  WAIT_BAR(4);
  { const unsigned tb0_=TRB(0); const f32x16 c0_=BIASC(0,kbA0,locA,tb0_), c1_=BIASC(0,kbB0,locB,tb0_); qkt(pA0,pA1,Kbase,qr,c0_,c1_,r32,hi); } asm volatile("s_nop 15\n\ts_nop 7":"+v"(pA0),"+v"(pA1));CMASK(pA0,pA1,0);
  START(pA0,pA1);
  _Pragma("unroll") for(int r=0;r<16;++r)pA1[r]=__builtin_amdgcn_exp2f(pA1[r]);
  WAIT_BAR(0);
  DMA_K(3,0);DMA_V(1,SLOTB);
  ROT();
  kload8(kf,kp0+sl_cur);
  WAIT_BAR(3);
  s16x4 vlo[8],vhi[8]; u32x4 pw0,pw1,pw2,pw3;
  #define PKW(P,B) cvtpk_s(P[B],P[B+1])
  #define PAF(k) __builtin_bit_cast(bf16x8,pw##k)
  #define VFR(i) (bf16x8){vlo[i][0],vlo[i][1],vlo[i][2],vlo[i][3],vhi[i][0],vhi[i][1],vhi[i][2],vhi[i][3]}
  #define PIN(x) asm volatile("":"+v"(x))
  #define MX3(a,b,c) __builtin_fmaxf(__builtin_fmaxf((a),(b)),(c))
  #define GAPA(MF,A0,A1,A2,A3,W0,W1,PW) do{ MF; sacc+=A0; sacc+=A1; sacc+=A2; sacc+=A3; PIN(sacc); W0; W1; PIN(PW); SBAR(); }while(0)
  #define EX(v) __builtin_amdgcn_exp2f(v)
  #define GAPB(MF,X,B) do{ MF; X[B]=EX(X[B]); X[B+1]=EX(X[B+1]); X[B+2]=EX(X[B+2]); X[B+3]=EX(X[B+3]); PIN(X); SBAR(); }while(0)
  #define VRD(s_,db_,ks_) do{ vlo[s_]=vtr(vp_+((db_)*4096+(ks_)*1024)); vhi[s_]=vtr(vp_+((db_)*4096+(ks_)*1024+512)); }while(0)
  #define GAPB2(MF,X,B) do{ MF; X[B]=EX(X[B]); X[B+1]=EX(X[B+1]); PIN(X); SBAR(); }while(0)
  #define KRD(G,j) do{ if(G){ kload2(kf,kp0+sl_next,j); SBAR(); } }while(0)
  #define STEP(C0,C1,P0,P1,t,GK,GV,GL) do{ SBAR(); \
    const lds_cptr vp_=vp0+2*sl_prev; \
    const unsigned tb_=TRB(t); \
    VRD(0,0,0); SBAR(); float sacc=(P0[0]+P0[1]); \
    GAPA(C0=__builtin_amdgcn_mfma_f32_32x32x16_bf16(kf[0],qr[0],BIASC(t,kbA0,locA,tb_),0,0,0), P0[2],P0[3],P0[4],P0[5],     pw0[0]=PKW(P0,0), pw0[1]=PKW(P0,2), pw0); \
    VRD(1,1,0); SBAR(); GAPA(C1=__builtin_amdgcn_mfma_f32_32x32x16_bf16(kf[1],qr[0],BIASC(t,kbB0,locB,tb_),0,0,0), P0[6],P0[7],P0[8],P0[9],     pw0[2]=PKW(P0,4), pw0[3]=PKW(P0,6), pw0); \
    VRD(2,2,0); SBAR(); GAPA(C0=__builtin_amdgcn_mfma_f32_32x32x16_bf16(kf[2],qr[1],C0,0,0,0),   P0[10],P0[11],P0[12],P0[13], pw1[0]=PKW(P0,8), pw1[1]=PKW(P0,10), pw1); \
    VRD(3,3,0); SBAR(); GAPA(C1=__builtin_amdgcn_mfma_f32_32x32x16_bf16(kf[3],qr[1],C1,0,0,0),   P0[14],P0[15],P1[0],P1[1],   pw1[2]=PKW(P0,12),pw1[3]=PKW(P0,14), pw1); \
    VRD(4,0,1); SBAR(); GAPA(C0=__builtin_amdgcn_mfma_f32_32x32x16_bf16(kf[4],qr[2],C0,0,0,0),   P1[2],P1[3],P1[4],P1[5],     pw2[0]=PKW(P1,0), pw2[1]=PKW(P1,2), pw2); \
    VRD(5,1,1); SBAR(); GAPA(C1=__builtin_amdgcn_mfma_f32_32x32x16_bf16(kf[5],qr[2],C1,0,0,0),   P1[6],P1[7],P1[8],P1[9],     pw2[2]=PKW(P1,4), pw2[3]=PKW(P1,6), pw2); \
    VRD(6,2,1); SBAR(); GAPA(C0=__builtin_amdgcn_mfma_f32_32x32x16_bf16(kf[6],qr[3],C0,0,0,0),   P1[10],P1[11],P1[12],P1[13], pw3[0]=PKW(P1,8), pw3[1]=PKW(P1,10), pw3); \
    VRD(7,3,1); SBAR(); GAPA(C1=__builtin_amdgcn_mfma_f32_32x32x16_bf16(kf[7],qr[3],C1,0,0,0),   P1[14],P1[15],0.f,0.f,       pw3[2]=PKW(P1,12),pw3[3]=PKW(P1,14), pw3); \
    l_reg+=sacc; \
    if(GK){DMA_K((t)+3,sl_cur);} if(GV){DMA_V((t)+1,sl_next);} \
    CMASK(C0,C1,t); \
    { float a=MX3(C0[0],C0[1],C1[0]),b=MX3(C0[2],C0[3],C1[1]); a=MX3(a,C1[2],C1[3]); \
      _Pragma("unroll") for(int r=4;r<16;r+=4){a=MX3(a,C0[r],C0[r+1]);b=MX3(b,C0[r+2],C0[r+3]);a=MX3(a,C1[r],C1[r+1]);b=MX3(b,C1[r+2],C1[r+3]);} \
      float rm=__builtin_fmaxf(a,b); { auto rr=__builtin_amdgcn_permlane32_swap(__float_as_uint(rm),__float_as_uint(rm),false,false); rm=__builtin_fmaxf(__uint_as_float(rr[0]),__uint_as_float(rr[1])); } \
      resc=false; \
      if(__builtin_expect(__any(rm>(float)THRL),0)){ const float dl=__builtin_ceilf(__builtin_fmaxf(rm,0.f)); mhat+=dl; \
        _Pragma("unroll") for(int r=0;r<16;++r){C0[r]-=dl;C1[r]-=dl;} \
        SETM(); \
        const float f=__builtin_amdgcn_exp2f(-dl); l_reg*=f; if(hi==0)wsf[r32]=f; resc=true; } } \
    SBAR(); \
    GAPB2(o[0]=__builtin_amdgcn_mfma_f32_32x32x16_bf16(PAF(0),VFR(0),o[0],0,0,0), C0,0); VRD(0,0,2); SBAR(); \
    GAPB2(o[1]=__builtin_amdgcn_mfma_f32_32x32x16_bf16(PAF(0),VFR(1),o[1],0,0,0), C0,2); VRD(1,1,2); SBAR(); \
    GAPB2(o[2]=__builtin_amdgcn_mfma_f32_32x32x16_bf16(PAF(0),VFR(2),o[2],0,0,0), C0,4); VRD(2,2,2); SBAR(); \
    GAPB2(o[3]=__builtin_amdgcn_mfma_f32_32x32x16_bf16(PAF(0),VFR(3),o[3],0,0,0), C0,6); VRD(3,3,2); SBAR(); \
    GAPB2(o[0]=__builtin_amdgcn_mfma_f32_32x32x16_bf16(PAF(1),VFR(4),o[0],0,0,0), C0,8); VRD(4,0,3); SBAR(); \
    GAPB2(o[1]=__builtin_amdgcn_mfma_f32_32x32x16_bf16(PAF(1),VFR(5),o[1],0,0,0), C0,10); VRD(5,1,3); SBAR(); \
    GAPB2(o[2]=__builtin_amdgcn_mfma_f32_32x32x16_bf16(PAF(1),VFR(6),o[2],0,0,0), C0,12); VRD(6,2,3); SBAR(); \
    GAPB2(o[3]=__builtin_amdgcn_mfma_f32_32x32x16_bf16(PAF(1),VFR(7),o[3],0,0,0), C0,14); VRD(7,3,3); SBAR(); \
    KRD(GL,0); GAPB2(o[0]=__builtin_amdgcn_mfma_f32_32x32x16_bf16(PAF(2),VFR(0),o[0],0,0,0), C1,0); \
    KRD(GL,1); GAPB2(o[1]=__builtin_amdgcn_mfma_f32_32x32x16_bf16(PAF(2),VFR(1),o[1],0,0,0), C1,2); \
    KRD(GL,2); GAPB2(o[2]=__builtin_amdgcn_mfma_f32_32x32x16_bf16(PAF(2),VFR(2),o[2],0,0,0), C1,4); \
    KRD(GL,3); GAPB2(o[3]=__builtin_amdgcn_mfma_f32_32x32x16_bf16(PAF(2),VFR(3),o[3],0,0,0), C1,6); \
    GAPB2(o[0]=__builtin_amdgcn_mfma_f32_32x32x16_bf16(PAF(3),VFR(4),o[0],0,0,0), C1,8); \
    GAPB2(o[1]=__builtin_amdgcn_mfma_f32_32x32x16_bf16(PAF(3),VFR(5),o[1],0,0,0), C1,10); \
    GAPB2(o[2]=__builtin_amdgcn_mfma_f32_32x32x16_bf16(PAF(3),VFR(6),o[2],0,0,0), C1,12); \
    GAPB2(o[3]=__builtin_amdgcn_mfma_f32_32x32x16_bf16(PAF(3),VFR(7),o[3],0,0,0), C1,14); \
    }while(0)
  int t=1;
  #undef CMASK
  #define CMASK(P0,P1,t) do{}while(0)
  for(;t+5<NT;t+=2){
    STEP(pB0,pB1,pA0,pA1,t,true,true,true);     WAIT_BAR(3); RESC(); ROT();
    STEP(pA0,pA1,pB0,pB1,t+1,true,true,true);   WAIT_BAR(3); RESC(); ROT();
  }
  #undef CMASK
  #define CMASK(P0,P1,t) do{int jb_=(t)-(NT-4); if(jb_>=0)cmask(P0,P1,jb_,qrel,hi);}while(0)
  #define ENDW(tt) do{ if((tt)+3<NT){WAIT_BAR(3);} else if((tt)+2<NT){WAIT_BAR(2);} else {WAIT_BAR(0);} }while(0)
  for(;t+1<NT;t+=2){
    STEP(pB0,pB1,pA0,pA1,t,(t+3<NT),(t+1<NT),(t+1<NT));       ENDW(t);   RESC(); ROT();
    STEP(pA0,pA1,pB0,pB1,t+1,(t+4<NT),(t+2<NT),(t+2<NT));     ENDW(t+1); RESC(); ROT();
  }
  STEP(pB0,pB1,pA0,pA1,NT-1,false,false,false); RESC();
  { float sacc=pB0[0]+pB0[1]; _Pragma("unroll") for(int r=2;r<16;++r)sacc+=pB0[r]; _Pragma("unroll") for(int r=0;r<16;++r)sacc+=pB1[r]; l_reg+=sacc;
    pw0=(u32x4){PKW(pB0,0),PKW(pB0,2),PKW(pB0,4),PKW(pB0,6)};pw1=(u32x4){PKW(pB0,8),PKW(pB0,10),PKW(pB0,12),PKW(pB0,14)};pw2=(u32x4){PKW(pB1,0),PKW(pB1,2),PKW(pB1,4),PKW(pB1,6)};pw3=(u32x4){PKW(pB1,8),PKW(pB1,10),PKW(pB1,12),PKW(pB1,14)};
    SBAR(); pv(o,vb0+2*sl_cur,PAF(0),PAF(1),PAF(2),PAF(3)); }
  #undef PKW
  #undef PAF
  #undef VFR
  #undef PIN
  #undef MX3
  #undef GAPA
  #undef GAPB
  #undef GAPB2
  #undef EX
  #undef VRD
  #undef KRD
  #undef STEP
  #undef ENDW
  {auto rr=__builtin_amdgcn_permlane32_swap(__float_as_uint(l_reg),__float_as_uint(l_reg),false,false);l_reg=__uint_as_float(rr[0])+__uint_as_float(rr[1]);}
  if(hi==0)wsf[32+r32]=l_reg;asm volatile("s_waitcnt lgkmcnt(0)":::"memory");
  float rli[16];
  #pragma unroll
  for(int r=0;r<16;++r)rli[r]=__builtin_amdgcn_rcpf(wsf[32+crow(r,hi)]);
  bf16*Ow=O+(rowbase+q0+wid*QBLK)*OP;
  { bf16*stg=(bf16*)(shm+LDS_OST)+wid*4096;
    #pragma unroll
    for(int r=0;r<16;++r){const int orow=crow(r,hi);
      #pragma unroll
      for(int d0=0;d0<4;++d0)stg[orow*128+d0*32+r32]=__float2bfloat16(o[d0][r]*rli[r]);}
    asm volatile("s_waitcnt lgkmcnt(0)":::"memory");
    if(F_fmode==1){
      const __amdgpu_buffer_rsrc_t orr=__builtin_amdgcn_make_buffer_rsrc((void*)Ow,0,0x7fffffff,0x00020000);
      #pragma unroll
      for(int i=0;i<8;++i){const int row=i*4+(lane>>4),ch=lane&15; const u32x4 v=*(const u32x4*)(stg+row*128+ch*8); __builtin_amdgcn_raw_buffer_store_b128(v,orr,(unsigned)((row*OP+ch*8)*2),0,16);}
      asm volatile("s_waitcnt vmcnt(0) lgkmcnt(0)\n\ts_barrier":::"memory");
      if(tid==0)__hip_atomic_store(F_flag,1u,__ATOMIC_RELAXED,__HIP_MEMORY_SCOPE_AGENT);
    } else {
      if(tid==0){ unsigned sp_=0; while(__hip_atomic_load(F_flag,__ATOMIC_RELAXED,__HIP_MEMORY_SCOPE_AGENT)==0u){ __builtin_amdgcn_s_sleep(2); if(++sp_>(1u<<22))break; }
        __builtin_amdgcn_fence(__ATOMIC_ACQUIRE,"agent"); asm volatile("s_waitcnt vmcnt(0)":::"memory"); }
      asm volatile("s_waitcnt lgkmcnt(0)\n\ts_barrier":::"memory");
      const int ch=lane&15; const float*sgp=F_sg+8*ch; const float gs=F_gscale,lam=F_lam;
      const f32x4_t g0=*(const f32x4_t*)sgp*gs,g1=*(const f32x4_t*)(sgp+4)*gs;
      unsigned short*mo=F_mixo+(rowbase+q0+wid*QBLK)*1024;
      u32x4 pv_[8];
      #pragma unroll
      for(int i=0;i<8;++i){const int row=i*4+(lane>>4); pv_[i]=*(const u32x4*)(Ow+(long)row*OP+ch*8);}
      #pragma unroll
      for(int i=0;i<8;++i){const int row=i*4+(lane>>4); const u32x4 a=*(const u32x4*)(stg+row*128+ch*8),c=pv_[i];
        #define BLO(w) __uint_as_float((w)<<16)
        #define BHI(w) __uint_as_float((w)&0xffff0000u)
        const f32x4_t v0=(f32x4_t){BLO(a.x),BHI(a.x),BLO(a.y),BHI(a.y)}-lam*(f32x4_t){BLO(c.x),BHI(c.x),BLO(c.y),BHI(c.y)};
        const f32x4_t v1=(f32x4_t){BLO(a.z),BHI(a.z),BLO(a.w),BHI(a.w)}-lam*(f32x4_t){BLO(c.z),BHI(c.z),BLO(c.w),BHI(c.w)};
        #undef BLO
        #undef BHI
        float sq=(v0[0]*v0[0]+v0[1]*v0[1])+(v0[2]*v0[2]+v0[3]*v0[3])+(v1[0]*v1[0]+v1[1]*v1[1])+(v1[2]*v1[2]+v1[3]*v1[3]);
        #pragma unroll
        for(int m_=1;m_<16;m_<<=1) sq+=__builtin_bit_cast(float,__builtin_amdgcn_ds_bpermute((lane^m_)<<2,__builtin_bit_cast(int,sq)));
        const float rstd=__builtin_amdgcn_rsqf(sq*(1.0f/128.0f)+1e-5f);
        const f32x4_t o0=v0*rstd*g0,o1=v1*rstd*g1;
        u32x4 w; w.x=cvtpk_s(o0[0],o0[1]); w.y=cvtpk_s(o0[2],o0[3]); w.z=cvtpk_s(o1[0],o1[1]); w.w=cvtpk_s(o1[2],o1[3]);
        *(u32x4*)(mo+(long)row*1024+ch*8)=w; }
      asm volatile("s_waitcnt lgkmcnt(0)\n\ts_barrier":::"memory");
    } }
  #undef DMA_K
  #undef TRB
  #undef SETM
  #undef KBIAS
  #undef BIASC
  #undef DMA_V
  #undef CMASK
  #undef START
  #undef RESC
  #undef ROT
}
constexpr int ATTN_LDS_BYTES=LDS_BYTES;
#undef SBAR
#undef WAIT_BAR
}

namespace sgu {
constexpr int SP = 136;
constexpr int HALF_LDS = 128 * SP * 2 + 512;
__device__ __forceinline__ void unit2(LAS unsigned char* lds, const bf16_t* z, bf16_t* mix, const float* ln_g, const float* ln_b, const float* w_s, const float* b_s, int itA, int itB) {
    int tid_ = threadIdx.x; asm volatile("" : "+v"(tid_));
    const int tid = tid_, lane = tid & 63, r32 = lane & 31, hi = lane >> 5; const int wid = __builtin_amdgcn_readfirstlane(tid >> 6);
    const int half = wid >> 2, tl = tid & 255, tb = wid & 3;
    const int it = half ? itB : itA; const bool act = it >= 0;
    const int chunk = act ? it >> 2 : 0, g = act ? it & 3 : 0;
    const size_t row0 = (size_t)chunk * 128;
    LAS bf16_t* Vt = (LAS bf16_t*)(lds + half * HALF_LDS);
    const int t = 32 * tb + r32, nks = 2 * tb + 2;
    const float* wrow = w_s + ((size_t)g * 128 + t) * 128 + 8 * hi;
    f32x4 wa[8], wb[8];
#pragma unroll
    for (int ks = 0; ks < 8; ++ks) { if (act && ks < nks) { wa[ks] = *(const f32x4*)(wrow + 16 * ks); wb[ks] = *(const f32x4*)(wrow + 16 * ks + 4); } else { wa[ks] = (f32x4){0.f, 0.f, 0.f, 0.f}; wb[ks] = wa[ks]; } }
    const float bias = b_s[g * 128 + t];
    const bf16_t* up = z + (row0 + t) * DIN + 1536 + g * 128 + 4 * hi; bf16_t* op = mix + (row0 + t) * D + 512 + g * 128 + 4 * hi;
    if (act) {
        const int s = tl >> 1, qd = tl & 1; const bf16_t* src = z + (row0 + s) * DIN + 2048 + g * 128 + 64 * qd;
        float v[64]; float sum = 0.f;
#pragma unroll
        for (int j = 0; j < 8; ++j) { const u32x4 w = *(const u32x4*)(src + 8 * j);
#pragma unroll
            for (int e = 0; e < 4; ++e) { const float a = gelu_t(bflo(w[e])), c = gelu_t(bfhi(w[e])); v[8 * j + 2 * e] = a; v[8 * j + 2 * e + 1] = c; sum += a + c; } }
        sum += shx(sum, 1, lane);
        const float mean = sum * (1.0f / 128.0f); float sq = 0.f;
#pragma unroll
        for (int j = 0; j < 64; ++j) { v[j] -= mean; sq += v[j] * v[j]; }
        sq += shx(sq, 1, lane);
        const float rstd = __builtin_amdgcn_rsqf(sq * (1.0f / 128.0f) + LN_EPS);
        const float* gp = ln_g + g * 128 + 64 * qd; const float* bp = ln_b + g * 128 + 64 * qd;
#pragma unroll
        for (int j = 0; j < 64; ++j) Vt[(64 * qd + j) * SP + s] = (bf16_t)f2bf(v[j] * rstd * gp[j] + bp[j]);
    }
    __syncthreads();
    if (act) {
        f32x16 acc[4]; acc[0] = f32x16{}; acc[1] = f32x16{}; acc[2] = f32x16{}; acc[3] = f32x16{};
#pragma unroll
        for (int ks = 0; ks < 8; ++ks) if (ks < nks) {
            const int s0 = 16 * ks + 8 * hi;
            u32x4 w; w.x = pk2(s0 <= t ? wa[ks][0] : 0.f, s0 + 1 <= t ? wa[ks][1] : 0.f); w.y = pk2(s0 + 2 <= t ? wa[ks][2] : 0.f, s0 + 3 <= t ? wa[ks][3] : 0.f);
            w.z = pk2(s0 + 4 <= t ? wb[ks][0] : 0.f, s0 + 5 <= t ? wb[ks][1] : 0.f); w.w = pk2(s0 + 6 <= t ? wb[ks][2] : 0.f, s0 + 7 <= t ? wb[ks][3] : 0.f);
            const bf16x8 bfrag = __builtin_bit_cast(bf16x8, w);
#pragma unroll
            for (int cc = 0; cc < 4; ++cc) { const bf16x8 af = *(const LAS bf16x8*)(Vt + (32 * cc + r32) * SP + 16 * ks + 8 * hi);
                acc[cc] = __builtin_amdgcn_mfma_f32_32x32x16_bf16(af, bfrag, acc[cc], 0, 0, 0); }
        }
#pragma unroll
        for (int cc = 0; cc < 4; ++cc) {
            u32x2 uw[4];
#pragma unroll
            for (int q4 = 0; q4 < 4; ++q4) uw[q4] = *(const u32x2*)(up + 32 * cc + 8 * q4);
#pragma unroll
            for (int q4 = 0; q4 < 4; ++q4) { const u32x2 u2 = uw[q4];
                const float o0 = gelu_t(bflo(u2.x)) * (acc[cc][4 * q4] + bias), o1 = gelu_t(bfhi(u2.x)) * (acc[cc][4 * q4 + 1] + bias);
                const float o2 = gelu_t(bflo(u2.y)) * (acc[cc][4 * q4 + 2] + bias), o3 = gelu_t(bfhi(u2.y)) * (acc[cc][4 * q4 + 3] + bias);
                u32x2 w; w.x = cvtpk(o0, o1); w.y = cvtpk(o2, o3); *(u32x2*)(op + 32 * cc + 8 * q4) = w; }
        }
    }
    __syncthreads();
}
constexpr int QUARTER_LDS = 128 * SP * 2 + 512;
__device__ __forceinline__ void unit4(LAS unsigned char* lds, const bf16_t* z, bf16_t* mix, const float* ln_g, const float* ln_b, const float* w_s, const float* b_s, int it0, int it1, int it2, int it3) {
    int tid_ = threadIdx.x; asm volatile("" : "+v"(tid_));
    const int tid = tid_, lane = tid & 63, r32 = lane & 31, hi = lane >> 5; const int wid = __builtin_amdgcn_readfirstlane(tid >> 6);
    const int qt = wid >> 1, wq = wid & 1, tq = tid & 127;
    const int it = qt == 0 ? it0 : qt == 1 ? it1 : qt == 2 ? it2 : it3; const bool act = it >= 0;
    const int chunk = act ? it >> 2 : 0, g = act ? it & 3 : 0;
    const size_t row0 = (size_t)chunk * 128;
    LAS bf16_t* Vt = (LAS bf16_t*)(lds + qt * QUARTER_LDS);
    if (act) {
        const bf16_t* src = z + (row0 + tq) * DIN + 2048 + g * 128;
        unsigned vp[64]; float sum = 0.f, sq = 0.f;
#pragma unroll
        for (int j = 0; j < 16; ++j) { const u32x4 w = *(const u32x4*)(src + 8 * j);
#pragma unroll
            for (int e = 0; e < 4; ++e) { const f32x2 gv = gelu_t2((f32x2){bflo(w[e]), bfhi(w[e])}); vp[4 * j + e] = cvtpk(gv.x, gv.y); sum += gv.x + gv.y; sq += gv.x * gv.x + gv.y * gv.y; } }
        const float mean = sum * (1.0f / 128.0f);
        const float rstd = __builtin_amdgcn_rsqf(fmaxf(sq * (1.0f / 128.0f) - mean * mean, 0.f) + LN_EPS);
        const float* gp = ln_g + g * 128; const float* bp = ln_b + g * 128;
#pragma unroll
        for (int j = 0; j < 64; ++j) { const f32x2 nv = (((f32x2){bflo(vp[j]), bfhi(vp[j])} - mean) * rstd) * (f32x2){gp[2 * j], gp[2 * j + 1]} + (f32x2){bp[2 * j], bp[2 * j + 1]};
            const unsigned w = cvtpk(nv.x, nv.y);
            Vt[(2 * j) * SP + tq] = (bf16_t)(w & 0xffffu); Vt[(2 * j + 1) * SP + tq] = (bf16_t)(w >> 16); }
    }
    __syncthreads();
    if (act) {
#pragma unroll
        for (int pass = 0; pass < 2; ++pass) {
            const int tb = pass == 0 ? (wq ? 1 : 0) : (wq ? 2 : 3); const int t = 32 * tb + r32, nks = 2 * tb + 2;
            const float* wrow = w_s + ((size_t)g * 128 + t) * 128 + 8 * hi;
            f32x4 wa[8], wb[8];
#pragma unroll
            for (int ks = 0; ks < 8; ++ks) { if (ks < nks) { wa[ks] = *(const f32x4*)(wrow + 16 * ks); wb[ks] = *(const f32x4*)(wrow + 16 * ks + 4); } else { wa[ks] = (f32x4){0.f, 0.f, 0.f, 0.f}; wb[ks] = wa[ks]; } }
            const float bias = b_s[g * 128 + t];
            const bf16_t* up = z + (row0 + t) * DIN + 1536 + g * 128 + 4 * hi; bf16_t* op = mix + (row0 + t) * D + 512 + g * 128 + 4 * hi;
            u32x2 uw[16];
#pragma unroll
            for (int j = 0; j < 16; ++j) uw[j] = *(const u32x2*)(up + 8 * j);
            f32x16 acc[4]; acc[0] = f32x16{}; acc[1] = f32x16{}; acc[2] = f32x16{}; acc[3] = f32x16{};
#pragma unroll
            for (int ks = 0; ks < 8; ++ks) if (ks < nks) {
                const int s0 = 16 * ks + 8 * hi;
                u32x4 w; w.x = pk2(s0 <= t ? wa[ks][0] : 0.f, s0 + 1 <= t ? wa[ks][1] : 0.f); w.y = pk2(s0 + 2 <= t ? wa[ks][2] : 0.f, s0 + 3 <= t ? wa[ks][3] : 0.f);
                w.z = pk2(s0 + 4 <= t ? wb[ks][0] : 0.f, s0 + 5 <= t ? wb[ks][1] : 0.f); w.w = pk2(s0 + 6 <= t ? wb[ks][2] : 0.f, s0 + 7 <= t ? wb[ks][3] : 0.f);
                const bf16x8 bfrag = __builtin_bit_cast(bf16x8, w);
#pragma unroll
                for (int cc = 0; cc < 4; ++cc) { const bf16x8 af = *(const LAS bf16x8*)(Vt + (32 * cc + r32) * SP + 16 * ks + 8 * hi);
                    acc[cc] = __builtin_amdgcn_mfma_f32_32x32x16_bf16(af, bfrag, acc[cc], 0, 0, 0); }
            }
#pragma unroll
            for (int cc = 0; cc < 4; ++cc)
#pragma unroll
                for (int q4 = 0; q4 < 4; ++q4) { const u32x2 u2 = uw[4 * cc + q4];
                    const f32x2 oa = gelu_t2((f32x2){bflo(u2.x), bfhi(u2.x)}) * ((f32x2){acc[cc][4 * q4], acc[cc][4 * q4 + 1]} + bias);
                    const f32x2 ob = gelu_t2((f32x2){bflo(u2.y), bfhi(u2.y)}) * ((f32x2){acc[cc][4 * q4 + 2], acc[cc][4 * q4 + 3]} + bias);
                    u32x2 w; w.x = cvtpk(oa.x, oa.y); w.y = cvtpk(ob.x, ob.y); *(u32x2*)(op + 32 * cc + 8 * q4) = w; }
        }
    }
    __syncthreads();
}
}
constexpr int CV_DEFER = 1984;
constexpr int CV_IN = (D / 64) * (DIN / 32), CV_OUT = (D / 64) * (D / 32), CV_UP = (D / 64) * (NUP / 32), CV_DN = (DFF / 64) * (D / 32), CV_L = CV_IN + CV_OUT + CV_UP + CV_DN;
struct CvPtrs { const float *w_in, *norm1_g, *w_out, *w_up, *norm2_g, *w_down; };
__device__ __forceinline__ void cv_desc(int gi, const float* w_in, const float* norm1_g, const float* w_out, const float* w_up, const float* norm2_g, const float* w_down, unsigned char* ws,
                                        const float*& W, const float*& gk, bf16_t*& WT, int& K, int& N, int& k0, int& n0, int& mode) {
    const int l = gi / CV_L; int r = gi % CV_L; unsigned char* wl = ws + WS_W + l * W_LAYER;
    if (r < CV_IN) { W = w_in + (size_t)l * D * DIN; gk = norm1_g + l * D; WT = (bf16_t*)(wl + W_IN); K = D; N = DIN; mode = 1; }
    else if ((r -= CV_IN) < CV_OUT) { W = w_out + (size_t)l * D * D; gk = nullptr; WT = (bf16_t*)(wl + W_OUT); K = D; N = D; mode = 0; }
    else if ((r -= CV_OUT) < CV_UP) { W = w_up + (size_t)l * D * NUP; gk = norm2_g + l * D; WT = (bf16_t*)(wl + W_UP); K = D; N = NUP; mode = 2; }
    else { r -= CV_UP; W = w_down + (size_t)l * DFF * D; gk = nullptr; WT = (bf16_t*)(wl + W_DOWN); K = DFF; N = D; mode = 0; }
    const int nblk = N / 32; k0 = 64 * (r / nblk); n0 = 32 * (r % nblk);
}
__device__ __forceinline__ void cv_load(float (&wv)[32], const float* W, int N, int k0, int n0, int lane) {
#pragma unroll
    for (int i = 0; i < 32; ++i) wv[i] = __builtin_nontemporal_load(W + (size_t)(k0 + 2 * i + (lane >> 5)) * N + n0 + (lane & 31));
}
__device__ __forceinline__ void cv_finish(const float (&wv)[32], const float* gk, bf16_t* WT, int K, int k0, int n0, int mode, LAS float* scr, int lane) {
    const float cs = (mode == 1 && n0 < 512) ? QSCALE : 1.0f;
#pragma unroll
    for (int i = 0; i < 32; ++i) { const int kk = 2 * i + (lane >> 5); float v = wv[i];
        if (mode != 0) v *= gk[k0 + kk] * cs;
        scr[kk * 33 + (lane & 31)] = v; }
    asm volatile("s_waitcnt lgkmcnt(0)" ::: "memory");
    const int c = lane & 7;
    int d0 = n0;
    if (mode == 2) { const int half = n0 >= DFF ? 1 : 0, cc = n0 - half * DFF; d0 = 256 * (cc >> 7) + 128 * half + (cc & 127); }
#pragma unroll
    for (int j = 0; j < 4; ++j) { const int n = (lane >> 3) + 8 * j; const LAS float* s = scr + (8 * c) * 33 + n;
        u32x4 o; o.x = pk2(s[0 * 33], s[1 * 33]); o.y = pk2(s[2 * 33], s[3 * 33]); o.z = pk2(s[4 * 33], s[5 * 33]); o.w = pk2(s[6 * 33], s[7 * 33]);
        *(u32x4*)(WT + (size_t)(d0 + n) * K + k0 + 8 * c) = o; }
    asm volatile("s_waitcnt lgkmcnt(0)" ::: "memory");
}
__device__ __forceinline__ void convert_weights(const float* w_in, const float* norm1_g, const float* w_out, const float* w_up, const float* norm2_g, const float* w_down, unsigned char* ws, LAS float* scr, int lane, int first, int stride, int total) {
    if (first >= total) return;
    const float *W, *gk; bf16_t* WT; int K, N, k0, n0, mode; float wv[32];
    cv_desc(first, w_in, norm1_g, w_out, w_up, norm2_g, w_down, ws, W, gk, WT, K, N, k0, n0, mode);
    cv_load(wv, W, N, k0, n0, lane);
    for (int gi = first;;) {
        const int g2 = gi + stride; const bool has = g2 < total;
        const float *W2 = W, *gk2 = gk; bf16_t* WT2 = WT; int K2 = K, N2 = N, k02 = k0, n02 = n0, mode2 = mode; float wv2[32];
        if (has) { cv_desc(g2, w_in, norm1_g, w_out, w_up, norm2_g, w_down, ws, W2, gk2, WT2, K2, N2, k02, n02, mode2); cv_load(wv2, W2, N2, k02, n02, lane); }
        cv_finish(wv, gk, WT, K, k0, n0, mode, scr, lane);
        if (!has) break;
        W = W2; gk = gk2; WT = WT2; K = K2; N = N2; k0 = k02; n0 = n02; mode = mode2; gi = g2;
#pragma unroll
        for (int i = 0; i < 32; ++i) wv[i] = wv2[i];
    }
}

#define XB_TMO      128
#define XB_XCNT(j)  (256  + 64 * (j))
#define XB_XSUB(j)  (1280 + 64 * (j))
#define XB_XGEN(j)  (2304 + 64 * (j))
#define XB_TOP      3328
#define XB_TOPGEN   3392
#define XCD_BAR_WORDS 3456
#define XB_SPIN_CAP (1u << 18)

__device__ __forceinline__ unsigned xb_ld(unsigned* p)              { return __hip_atomic_load(p, __ATOMIC_RELAXED, __HIP_MEMORY_SCOPE_AGENT); }
__device__ __forceinline__ unsigned xb_add(unsigned* p, unsigned v) { return __hip_atomic_fetch_add(p, v, __ATOMIC_RELAXED, __HIP_MEMORY_SCOPE_AGENT); }
__device__ __forceinline__ unsigned xb_xcc_id() { return (unsigned)__builtin_amdgcn_s_getreg((3 << 11) | 20) & 0xFu; }
#define XB_SPIN(cond, bar) do { unsigned _sp = 0; while (cond) { __builtin_amdgcn_s_sleep(1); \
    if ((++_sp & 255u) == 0u) { if (xb_ld(&(bar)[XB_TMO])) break; if (_sp > XB_SPIN_CAP) { atomicAdd(&(bar)[XB_TMO], 1u); break; } } } } while (0)

struct XcdBarrier {
    unsigned* bar; unsigned x;
    volatile LAS unsigned* st;
};

__device__ __forceinline__ XcdBarrier xcd_barrier_post(unsigned* bar, volatile LAS unsigned* st) {
    XcdBarrier b; b.bar = bar; b.x = xb_xcc_id(); b.st = st;
    if (threadIdx.x == 0) (void)xb_add(&bar[XB_XCNT(b.x)], 1u);
    return b;
}
__device__ __forceinline__ void xcd_barrier_complete(unsigned* bar, unsigned x, unsigned& nloc, unsigned& nx) {
    const unsigned G = gridDim.x * gridDim.y * gridDim.z;
    unsigned sum, cnt, mine, sp = 0u;
    for (;;) {
        sum = 0u; cnt = 0u; mine = 0u;
#pragma unroll
        for (unsigned j = 0; j < 16; ++j) { const unsigned c = xb_ld(&bar[XB_XCNT(j)]); sum += c; cnt += (c > 0u) ? 1u : 0u; mine = (j == x) ? c : mine; }
        if (sum == G) break;
        __builtin_amdgcn_s_sleep(1);
        if ((++sp & 255u) == 0u) { if (xb_ld(&bar[XB_TMO])) break; if (sp > XB_SPIN_CAP) { atomicAdd(&bar[XB_TMO], 1u); break; } }
    }
    nloc = mine > 0u ? mine : 1u; nx = cnt > 0u ? cnt : 1u;
}

__device__ __forceinline__ void xcd_barrier(const XcdBarrier& b) {
    asm volatile("s_waitcnt vmcnt(0)" ::: "memory");
    __syncthreads();
    if (threadIdx.x == 0) {
        unsigned* bar = b.bar;
        __builtin_amdgcn_s_waitcnt(0);
        unsigned nloc = b.st[0], nx = b.st[1];
        if (nloc == 0u) { xcd_barrier_complete(bar, b.x, nloc, nx); b.st[0] = nloc; b.st[1] = nx; }
        const unsigned old = xb_add(&bar[XB_XSUB(b.x)], 1u);
        const unsigned gen = old / nloc;
        if (old + 1u == (gen + 1u) * nloc) {
            __builtin_amdgcn_fence(__ATOMIC_RELEASE, "agent");
            asm volatile("s_waitcnt vmcnt(0)" ::: "memory");
            const unsigned og = xb_add(&bar[XB_TOP], 1u);
            const unsigned tg = og / nx;
            if (og + 1u == (tg + 1u) * nx) xb_add(&bar[XB_TOPGEN], 1u);
            else XB_SPIN(xb_ld(&bar[XB_TOPGEN]) == tg, bar);
            __builtin_amdgcn_fence(__ATOMIC_ACQUIRE, "agent");
            xb_add(&bar[XB_XGEN(b.x)], 1u);
            asm volatile("s_waitcnt vmcnt(0)" ::: "memory");
        } else {
            XB_SPIN(xb_ld(&bar[XB_XGEN(b.x)]) == gen, bar);
            __builtin_amdgcn_fence(__ATOMIC_ACQUIRE, "agent");
            asm volatile("s_waitcnt vmcnt(0)" ::: "memory");
        }
    }
    __syncthreads();
}

struct Params {
    const float *x, *norm1_g, *w_in, *lam_q1, *lam_k1, *lam_q2, *lam_k2, *subln_g, *sgu_ln_g, *sgu_ln_b, *sgu_w, *sgu_b, *w_out, *norm2_g, *ffn_w_up, *ffn_conv_w, *ffn_conv_b, *ffn_w_down, *final_g;
    float* out; unsigned char* ws;
};

#define CAS __attribute__((address_space(4)))
#define LOADP() const CAS Params* pp = (const CAS Params*)__builtin_amdgcn_kernarg_segment_ptr(); asm volatile("" : "+s"(pp)); unsigned char* ws = pp->ws; float* ss = (float*)(ws + WS_SS)
#define GRID_BAR() do { const CAS Params* ppb = (const CAS Params*)__builtin_amdgcn_kernarg_segment_ptr(); asm volatile("" : "+s"(ppb)); XcdBarrier b_; b_.bar = (unsigned*)(ppb->ws + WS_CTL); b_.x = xb_xcc_id(); \
        b_.st = (volatile LAS unsigned*)((LAS unsigned char*)lds_raw + LDS_BYTES - 64); xcd_barrier(b_); } while (0)

template <int l> __device__ __forceinline__ void layer_body(LAS unsigned char* lds, unsigned char* lds_raw, const int G, const int bx, const int vcu) {
#if PH & 1
        {
            LOADP(); unsigned char* wl = ws + WS_W + l * W_LAYER;
            pg8::Gemm g{(const bf16_t*)(ws + WS_XB), (const bf16_t*)(wl + W_IN), M, DIN, D, 256, 128, 0};
            int Gl = G, bxl = bx; asm volatile("" : "+s"(Gl), "+s"(bxl));
            const bool fused = FUSE_SGU && (Gl == 256);
            unsigned* cnt = (unsigned*)(ws + WS_CTL) + 8192 + 64 * l;
            InProjOrder S; S.init(G, bx, cnt, fused);
            fill_rstd<false>(lds, S, ss);
            EpiInProj E{(bf16_t*)(ws + WS_Z), (LAS const float*)(lds + RSTAB_OFF), fused};
            for (int rep = 0; rep < REP_P1; ++rep) pg8::gemm_phase<EpiInProj, InProjOrder, true, true>(lds, g, S, E);
            if (fused && bxl >= 128) {
                if (threadIdx.x == 0) { unsigned sp = 0;
                    while (__hip_atomic_load(cnt, __ATOMIC_RELAXED, __HIP_MEMORY_SCOPE_AGENT) < 256u * REP_P1) { __builtin_amdgcn_s_sleep(2); if (++sp > (1u << 22)) break; }
                    __builtin_amdgcn_fence(__ATOMIC_ACQUIRE, "agent"); asm volatile("s_waitcnt vmcnt(0)" ::: "memory"); }
                __syncthreads();
                const bf16_t* zb = (const bf16_t*)(ws + WS_Z); bf16_t* mix = (bf16_t*)(ws + WS_MIX);
                { const int it = bxl - 128; sgu::unit4(lds, zb, mix, pp->sgu_ln_g + l * 512, pp->sgu_ln_b + l * 512, pp->sgu_w + (size_t)l * 4 * 128 * 128, pp->sgu_b + l * 512, it, it + 128, it + 256, it + 384); }
            }
        }
        GRID_BAR();
#endif
#if PH & 2
        {
            LOADP(); (void)ss; int tid = threadIdx.x; asm volatile("" : "+v"(tid)); const int lane = tid & 63;
            const attn_body::bf16* z = (const attn_body::bf16*)(ws + WS_Z); attn_body::bf16* opart = (attn_body::bf16*)(ws + WS_OP1);
            const int bhr = vcu >> 4, s16 = vcu & 15, b = bhr >> 3, h = (bhr >> 1) & 3, br = bhr & 1;
            const float slope2 = exp2f(-2.0f * (float)(h + 1)) * LOG2E;
            const float lam_init = 0.8f - 0.6f * expf(-0.3f * (float)l);
            const float d1 = wave_sum(pp->lam_q1[l * 64 + lane] * pp->lam_k1[l * 64 + lane], lane), d2 = wave_sum(pp->lam_q2[l * 64 + lane] * pp->lam_k2[l * 64 + lane], lane);
            const float lam = __builtin_bit_cast(float, __builtin_amdgcn_readfirstlane(__builtin_bit_cast(int, expf(d1) - expf(d2) + lam_init)));
            unsigned* flags = (unsigned*)(ws + WS_CTL) + 9216 + ((l * 8 + b * 4 + h) * 32) * 16;
            if (vcu < 256)
                for (int i = 0; i < 2 * REP_ATT; ++i) { const int qb = (i & 1) ? s16 : 31 - s16;
                    attn_body::attn_unit<8>(b, qb, z + h * 128 + br * 64, z + 512 + h * 128 + br * 64, z + 1024 + h * 128, opart + h * 128, (char*)lds_raw, slope2, br, flags + qb * 16, (unsigned short*)(ws + WS_MIX) + h * 128, lam, 1.0f - lam_init, pp->subln_g + l * 128); }
        }
        GRID_BAR();
#endif
#if PH & 4
        {
            LOADP(); (void)ss;
            const bf16_t* zb = (const bf16_t*)(ws + WS_Z); bf16_t* mix = (bf16_t*)(ws + WS_MIX);
            int Gl = G; asm volatile("" : "+s"(Gl));
            if (!FUSE_SGU || Gl != 256) {
                for (int rs_ = 0; rs_ < REP_SGU * REP_P2B; ++rs_)
                for (int it = vcu; it < 512; it += 2 * G) sgu::unit2(lds, zb, mix, pp->sgu_ln_g + l * 512, pp->sgu_ln_b + l * 512, pp->sgu_w + (size_t)l * 4 * 128 * 128, pp->sgu_b + l * 512, it, it + G < 512 ? it + G : -1);
                GRID_BAR();
            }
        }
#endif
#if PH & 8
        {
            LOADP(); unsigned char* wl = ws + WS_W + l * W_LAYER;
            pg8::Gemm g{(const bf16_t*)(ws + WS_MIX), (const bf16_t*)(wl + W_OUT), M, D, D, 256, 128, 0}; pg8::StaticOrder S; S.init(M, D, G, bx);
            EpiRes E{nullptr, (bf16_t*)(ws + WS_XB), ss};
            pg8::gemm_phase<EpiRes, pg8::StaticOrder, true, true>(lds, g, S, E);
        }
        GRID_BAR();
#endif
#if PH & 16
        {
            LOADP(); unsigned char* wl = ws + WS_W + l * W_LAYER;
            pg8::Gemm g{(const bf16_t*)(ws + WS_XB) - 2 * D, (const bf16_t*)(wl + W_UP), P4_TILES * 256, NUP, D, P4_ROWS, P4_ROWS / 2, 2}; pg8::StaticOrder S; S.init(P4_TILES * 256, NUP, G, bx);
            fill_rstd<true>(lds, S, ss);
            EpiConvGate E{(bf16_t*)(ws + WS_Y), (LAS const float*)(lds + RSTAB_OFF), pp->ffn_conv_w + (size_t)l * 3 * NUP, pp->ffn_conv_b + (size_t)l * NUP};
            for (int rep = 0; rep < REP_P4; ++rep) pg8::gemm_phase<EpiConvGate, pg8::StaticOrder, true, true>(lds, g, S, E);
            if (l == 0) { int Gl = G, bxl = bx; asm volatile("" : "+s"(Gl), "+s"(bxl));
                if (Gl == 256 && bxl >= 194) {
                    int tid = threadIdx.x; asm volatile("" : "+v"(tid)); const int lane = tid & 63, wave = __builtin_amdgcn_readfirstlane(tid >> 6);
                    convert_weights(pp->w_in, pp->norm1_g, pp->w_out, pp->ffn_w_up, pp->norm2_g, pp->ffn_w_down, ws, (LAS float*)(lds + wave * 16384), lane, DEPTH * CV_L - CV_DEFER + (bxl - 194) * 8 + wave, 62 * 8, DEPTH * CV_L); } }
        }
        GRID_BAR();
#endif
#if PH & 32
        {
            LOADP(); unsigned char* wl = ws + WS_W + l * W_LAYER;
            pg8::Gemm g{(const bf16_t*)(ws + WS_Y), (const bf16_t*)(wl + W_DOWN), M, D, DFF, 256, 128, 0}; pg8::StaticOrder S; S.init(M, D, G, bx);
            int Gl = G; asm volatile("" : "+s"(Gl));
            if (l == DEPTH - 1 && Gl == 256) {
                EpiResFinal E{(const bf16_t*)(ws + WS_XB), ss, pp->out, pp->final_g, (unsigned*)(ws + WS_CTL) + 20480, (LAS float*)(lds + RSTAB_OFF)};
                pg8::gemm_phase<EpiResFinal, pg8::StaticOrder, true, true>(lds, g, S, E);
            } else {
                EpiRes E{nullptr, (bf16_t*)(ws + WS_XB), ss};
                pg8::gemm_phase<EpiRes, pg8::StaticOrder, true, true>(lds, g, S, E);
                GRID_BAR();
            }
        }
#endif
}

__global__ void __launch_bounds__(512, 2) fwd_megakernel(Params Punused) {
    extern __shared__ __attribute__((aligned(16))) unsigned char lds_raw[];
    LAS unsigned char* lds = (LAS unsigned char*)lds_raw;
    cg::grid_group grid = cg::this_grid();
    const int G = gridDim.x, bx = blockIdx.x;
    const int vcu = (G % 8 == 0) ? (bx % 8) * (G / 8) + bx / 8 : bx;
    volatile LAS unsigned* bst = (volatile LAS unsigned*)(lds + LDS_BYTES - 64);
    if (threadIdx.x < 2) bst[threadIdx.x] = 0u;
    __syncthreads();
    { const CAS Params* pp0 = (const CAS Params*)__builtin_amdgcn_kernarg_segment_ptr(); (void)xcd_barrier_post((unsigned*)(pp0->ws + WS_CTL), bst); }
    {
        LOADP(); int tid = threadIdx.x; asm volatile("" : "+v"(tid)); const int lane = tid & 63, wave = __builtin_amdgcn_readfirstlane(tid >> 6), gw = vcu * 8 + wave, NGW = G * 8;
        bf16_t* xb = (bf16_t*)(ws + WS_XB);
        LAS float* scr = (LAS float*)(lds + wave * 16384);
        for (int rep = 0; rep < REP_P0; ++rep) {
        convert_weights(pp->w_in, pp->norm1_g, pp->w_out, pp->ffn_w_up, pp->norm2_g, pp->ffn_w_down, ws, scr, lane, gw, NGW, DEPTH * CV_L - (G == 256 ? CV_DEFER : 0));
        const float* x = pp->x;
        for (int m0 = gw; m0 < M; m0 += 2 * NGW) {
            f32x4 v[2][4];
#pragma unroll
            for (int k = 0; k < 2; ++k) { const f32x4* xr = (const f32x4*)(x + (size_t)(m0 + k * NGW) * D) + lane;
#pragma unroll
                for (int j = 0; j < 4; ++j) v[k][j] = __builtin_nontemporal_load(xr + 64 * j); }
#pragma unroll
            for (int k = 0; k < 2; ++k) { const int m = m0 + k * NGW; float s = 0.f;
                unsigned long long* o8 = (unsigned long long*)(xb + (size_t)m * D) + lane;
#pragma unroll
                for (int j = 0; j < 4; ++j) { const f32x4 t = v[k][j]; s += (t[0] * t[0] + t[1] * t[1]) + (t[2] * t[2] + t[3] * t[3]);
                    o8[64 * j] = (unsigned long long)pk2(t[0], t[1]) | ((unsigned long long)pk2(t[2], t[3]) << 32); }
                s = wave_sum(s, lane);
                if (lane < 16) ss[(size_t)m * 16 + lane] = lane == 0 ? s : 0.f; }
        }
        }
    }
    if (gridDim.y == 7u) grid.sync();
    GRID_BAR();
    for (int rep = 0; rep < REP_SYNC; ++rep) GRID_BAR();

    layer_body<0>(lds, lds_raw, G, bx, vcu);
    layer_body<1>(lds, lds_raw, G, bx, vcu);
    if (G != 256) {
        LOADP(); int tid = threadIdx.x; asm volatile("" : "+v"(tid)); const int lane = tid & 63, wave = __builtin_amdgcn_readfirstlane(tid >> 6), gw = vcu * 8 + wave, NGW = G * 8;
        float* out = pp->out; const f32x4* gp = (const f32x4*)pp->final_g + lane;
        const bf16_t* xb = (const bf16_t*)(ws + WS_XB);
        f32x4 gv[4];
#pragma unroll
        for (int j = 0; j < 4; ++j) gv[j] = gp[64 * j];
        for (int m0 = gw; m0 < M; m0 += 2 * NGW) {
            u32x2 xv[2][4]; float rs[2];
#pragma unroll
            for (int k = 0; k < 2; ++k) { const int m = m0 + k * NGW; const u32x2* xr = (const u32x2*)(xb + (size_t)m * D) + lane;
#pragma unroll
                for (int j = 0; j < 4; ++j) xv[k][j] = xr[64 * j];
                rs[k] = row_rstd(ss, m, NORM_EPS); }
#pragma unroll
            for (int k = 0; k < 2; ++k) { const int m = m0 + k * NGW; f32x4* xr = (f32x4*)(out + (size_t)m * D) + lane;
#pragma unroll
                for (int j = 0; j < 4; ++j) xr[64 * j] = (f32x4){bflo(xv[k][j].x), bfhi(xv[k][j].x), bflo(xv[k][j].y), bfhi(xv[k][j].y)} * rs[k] * gv[j]; }
        }
    }
}

extern "C" void kernel_launch(void* const* d_in, const int* in_sizes, int n_in, void* d_out, int out_size, void* d_ws, size_t ws_size, hipStream_t stream) {
    static int grid = 0;
    if (grid == 0) {
        if (n_in != 19 || in_sizes[0] != M * D || out_size != M * D || ws_size < WS_END) { fprintf(stderr, "kernel_launch: unexpected shapes (n_in %d, ws %zu)\n", n_in, ws_size); grid = -1; return; }
        int dev = 0, cus = 0, per_cu = 0;
        hipGetDevice(&dev); hipDeviceGetAttribute(&cus, hipDeviceAttributeMultiprocessorCount, dev);
        if (hipFuncSetAttribute((const void*)fwd_megakernel, hipFuncAttributeMaxDynamicSharedMemorySize, LDS_BYTES) != hipSuccess) { fprintf(stderr, "kernel_launch: hipFuncSetAttribute failed\n"); grid = -1; return; }
        if (hipOccupancyMaxActiveBlocksPerMultiprocessor(&per_cu, (const void*)fwd_megakernel, 512, LDS_BYTES) != hipSuccess || per_cu < 1) { fprintf(stderr, "kernel_launch: occupancy query gave %d\n", per_cu); per_cu = 1; }
        (void)hipGetLastError();
        grid = cus;
    }
    if (grid < 0) return;
    if (hipMemsetAsync((char*)d_ws + WS_CTL, 0, CTL_BYTES, stream) != hipSuccess) { fprintf(stderr, "kernel_launch: memset failed\n"); return; }
    Params p{};
    const float** f = (const float**)&p;
    for (int i = 0; i < 19; ++i) f[i] = (const float*)d_in[i];
    p.out = (float*)d_out; p.ws = (unsigned char*)d_ws;
    void* args[] = {&p};
    const hipError_t e = hipLaunchCooperativeKernel((const void*)fwd_megakernel, dim3(grid), dim3(512), args, LDS_BYTES, stream);
    if (e != hipSuccess) fprintf(stderr, "kernel_launch: cooperative launch failed: %s (grid %d)\n", hipGetErrorString(e), grid);
}
```
